# Optimizing an MI355X kernel written in HIP

```python
import jax, jax.numpy as jnp
from jax import lax
import numpy as np

D_MODEL = 1024
BATCH = 8
SEQ = 2048
DEPTH = 2

FNET_GROUPS = 4
FNET_GROUP_DIM = 128
FNET_WIDTH = FNET_GROUPS * FNET_GROUP_DIM
ATTN_HEADS = 8
ATTN_KV_HEADS = 2
HEAD_DIM = 64
ATTN_WIDTH = ATTN_HEADS * HEAD_DIM
KV_WIDTH = ATTN_KV_HEADS * HEAD_DIM
WINDOW = 128
BLOCK = 128
REL_BUCKETS = 32
REL_MAX_DIST = 128
MIX_IN_WIDTH = FNET_WIDTH + ATTN_WIDTH + 2 * KV_WIDTH
MIX_OUT_WIDTH = FNET_WIDTH + ATTN_WIDTH
D_FF = 2816
D_INNER = 2 * D_MODEL
SSM_HEAD_DIM = 64
SSM_HEADS = D_INNER // SSM_HEAD_DIM
SSM_GROUPS = 4
D_STATE = 128
CONV_WIDTH = 5
SSD_CHUNK = 128
CONV_DIM = D_INNER + 2 * SSM_GROUPS * D_STATE
SSM_IN_WIDTH = D_INNER + CONV_DIM + 2 * SSM_HEADS
N_EXPERTS = 8
TOP_K = 2
D_FF_EXPERT = 3584
N_EVEN = (DEPTH + 1) // 2
N_ODD = DEPTH // 2
EPS = 1e-6

kernel_name = "hybrid_fnet_swa_ssd_moe_adaln"


def rms_norm(x, w):
    xf = x.astype(jnp.float32)
    y = xf * lax.rsqrt(jnp.mean(xf * xf, axis=-1, keepdims=True) + EPS)
    return (y * w.astype(jnp.float32)).astype(x.dtype)


def modulate(x, w, shift, scale):
    return rms_norm(x, w) * (1 + scale[:, None, :]) + shift[:, None, :]


def swiglu(t, w1, w3, w2):
    return (jax.nn.silu(t @ w1) * (t @ w3)) @ w2


def t5_band_buckets():
    i = np.arange(BLOCK)[:, None]
    j = np.arange(3 * BLOCK)[None, :]
    rel = (j - BLOCK) - i
    half = REL_BUCKETS // 2
    max_exact = half // 2
    n = np.abs(rel)
    large = max_exact + (np.log(np.maximum(n, 1) / max_exact)
                         / np.log(REL_MAX_DIST / max_exact) * (half - max_exact)).astype(np.int32)
    large = np.minimum(large, half - 1)
    bucket = (rel > 0).astype(np.int32) * half + np.where(n < max_exact, n, large)
    return bucket.astype(np.int32), rel


def band_mask(n_blk):
    _, rel = t5_band_buckets()
    kpos = (np.arange(n_blk)[:, None, None] * BLOCK
            + np.arange(3 * BLOCK)[None, None, :] - BLOCK)
    return (np.abs(rel)[None] <= WINDOW) & (kpos >= 0) & (kpos < n_blk * BLOCK)


def fourier_mix(u):
    b, s, _ = u.shape
    ug = u.astype(jnp.float32).reshape(b, s, FNET_GROUPS, FNET_GROUP_DIM)
    y = jnp.fft.fft2(ug, axes=(1, 3), norm="ortho").real
    return y.reshape(b, s, FNET_WIDTH).astype(u.dtype)


def window_gqa(q, k, v, rel_bias, sink):
    b, s = q.shape[0], q.shape[1]
    nb = s // BLOCK
    g = ATTN_HEADS // ATTN_KV_HEADS
    qb = q.reshape(b, nb, BLOCK, ATTN_KV_HEADS, g, HEAD_DIM)

    def band(t):
        tp = jnp.pad(t, ((0, 0), (BLOCK, BLOCK), (0, 0), (0, 0)))
        tp = tp.reshape(b, nb + 2, BLOCK, ATTN_KV_HEADS, HEAD_DIM)
        return jnp.concatenate([tp[:, :-2], tp[:, 1:-1], tp[:, 2:]], axis=2)

    kw, vw = band(k), band(v)
    bucket, _ = t5_band_buckets()
    bias = jnp.transpose(rel_bias[bucket].astype(jnp.float32), (2, 0, 1))
    bias = bias.reshape(ATTN_KV_HEADS, g, BLOCK, 3 * BLOCK)
    logits = jnp.einsum('bnqkgd,bnskd->bnkgqs', qb, kw).astype(jnp.float32) * (HEAD_DIM ** -0.5) + bias
    logits = jnp.where(band_mask(nb)[None, :, None, None], logits, -jnp.inf)
    sk = sink.astype(jnp.float32).reshape(ATTN_KV_HEADS, g)[None, None, :, :, None, None]
    m = jnp.maximum(jnp.max(logits, axis=-1, keepdims=True), sk)
    p = jnp.exp(logits - m)
    probs = p / (jnp.sum(p, axis=-1, keepdims=True) + jnp.exp(sk - m))
    out = jnp.einsum('bnkgqs,bnskd->bnqkgd', probs.astype(v.dtype), vw)
    return out.reshape(b, s, ATTN_WIDTH)


def even_mixer(h, in_w, q_norm_w, k_norm_w, sink, out_w, rel_bias):
    b, s, _ = h.shape
    proj = h @ in_w
    u, q, k, v = jnp.split(proj, [FNET_WIDTH, FNET_WIDTH + ATTN_WIDTH,
                                  FNET_WIDTH + ATTN_WIDTH + KV_WIDTH], axis=-1)
    q = rms_norm(q.reshape(b, s, ATTN_HEADS, HEAD_DIM), q_norm_w)
    k = rms_norm(k.reshape(b, s, ATTN_KV_HEADS, HEAD_DIM), k_norm_w)
    v = v.reshape(b, s, ATTN_KV_HEADS, HEAD_DIM)
    y = jnp.concatenate([fourier_mix(u), window_gqa(q, k, v, rel_bias, sink)], axis=-1)
    return y @ out_w


def ssd_scan(x, dt, A, Bm, Cm):
    b, s, h, p = x.shape
    nc = s // SSD_CHUNK
    r = SSM_HEADS // SSM_GROUPS
    X = (x * dt[..., None]).reshape(b, nc, SSD_CHUNK, SSM_GROUPS, r, p)
    a = (A * dt).reshape(b, nc, SSD_CHUNK, SSM_GROUPS, r).transpose(0, 3, 4, 1, 2)
    Bc = Bm.reshape(b, nc, SSD_CHUNK, SSM_GROUPS, D_STATE)
    Cc = Cm.reshape(b, nc, SSD_CHUNK, SSM_GROUPS, D_STATE)
    a_cum = jnp.cumsum(a, axis=-1)
    tril = np.tril(np.ones((SSD_CHUNK, SSD_CHUNK), dtype=bool))
    Lmat = jnp.exp(jnp.where(tril, a_cum[..., :, None] - a_cum[..., None, :], -jnp.inf))
    CB = jnp.einsum('bclgn,bcsgn->bgcls', Cc, Bc)
    y_diag = jnp.einsum('bgrcls,bcsgrp->bclgrp', CB[:, :, None] * Lmat, X)
    decay_states = jnp.exp(a_cum[..., -1:] - a_cum)
    states = jnp.einsum('bclgn,bgrcl,bclgrp->cbgrpn', Bc, decay_states, X)
    chunk_decay = jnp.exp(a_cum[..., -1]).transpose(3, 0, 1, 2)

    def step(hc, inp):
        st, dec = inp
        return hc * dec[..., None, None] + st, hc

    h0 = jnp.zeros(states.shape[1:], jnp.float32)
    _, prev = lax.scan(step, h0, (states, chunk_decay))
    y_off = jnp.einsum('bclgn,cbgrpn,bgrcl->bclgrp', Cc, prev, jnp.exp(a_cum))
    return (y_diag + y_off).reshape(b, s, h, p)


def ssd_mixer(h, in_w, conv_w, conv_b, dt_bias_f, dt_bias_b, A_log_f, A_log_b, D, gnorm_w, out_w):
    b, s, _ = h.shape
    proj = h @ in_w
    z, xbc, dt = jnp.split(proj, [D_INNER, D_INNER + CONV_DIM], axis=-1)
    xbc = lax.conv_general_dilated(xbc, conv_w[:, None, :], (1,),
                                   ((CONV_WIDTH // 2, CONV_WIDTH // 2),),
                                   dimension_numbers=('NWC', 'WIO', 'NWC'),
                                   feature_group_count=CONV_DIM)
    xbc = jax.nn.silu(xbc + conv_b)
    xs, Bm, Cm = jnp.split(xbc, [D_INNER, D_INNER + SSM_GROUPS * D_STATE], axis=-1)
    xs = xs.reshape(b, s, SSM_HEADS, SSM_HEAD_DIM).astype(jnp.float32)
    Bm = Bm.reshape(b, s, SSM_GROUPS, D_STATE).astype(jnp.float32)
    Cm = Cm.reshape(b, s, SSM_GROUPS, D_STATE).astype(jnp.float32)
    dt = dt.astype(jnp.float32)
    dt_f = jax.nn.softplus(dt[..., :SSM_HEADS] + dt_bias_f.astype(jnp.float32))
    dt_b = jax.nn.softplus(dt[..., SSM_HEADS:] + dt_bias_b.astype(jnp.float32))
    A_f = -jnp.exp(A_log_f.astype(jnp.float32))
    A_b = -jnp.exp(A_log_b.astype(jnp.float32))
    flip = lambda t: jnp.flip(t, axis=1)
    y_f = ssd_scan(xs, dt_f, A_f, Bm, Cm)
    y_b = flip(ssd_scan(flip(xs), flip(dt_b), A_b, flip(Bm), flip(Cm)))
    y = (y_f + y_b + D.astype(jnp.float32)[:, None] * xs).reshape(b, s, D_INNER)
    y = rms_norm(y * jax.nn.silu(z.astype(jnp.float32)), gnorm_w).astype(h.dtype)
    return y @ out_w


def moe_swiglu(h, router_w, router_b, w1, w3, w2):
    b, s, d = h.shape
    t = h.reshape(b * s, d)
    logits = (t @ router_w).astype(jnp.float32) + router_b.astype(jnp.float32)
    top_v, top_i = lax.top_k(logits, TOP_K)
    top_w = jax.nn.softmax(top_v, axis=-1)
    gates = jnp.sum(jax.nn.one_hot(top_i, N_EXPERTS, dtype=jnp.float32) * top_w[..., None], axis=1)
    out = jnp.zeros((b * s, d), jnp.float32)
    for e in range(N_EXPERTS):
        out = out + gates[:, e:e + 1] * swiglu(t, w1[e], w3[e], w2[e]).astype(jnp.float32)
    return out.reshape(b, s, d).astype(h.dtype)


def setup_inputs(seed: int = 0) -> dict:
    key = jax.random.key(seed)
    ks = iter(jax.random.split(key, 64))
    f32 = jnp.float32

    def nrm(shape, scale):
        return jax.random.normal(next(ks), shape, f32) * scale

    def gain(shape):
        return 1.0 + nrm(shape, 0.05)

    def dt_bias(shape):
        u = jax.random.uniform(next(ks), shape, f32, np.log(1e-3), np.log(1e-1))
        dt = jnp.exp(u)
        return dt + jnp.log(-jnp.expm1(-dt))

    def a_log(shape):
        return jnp.log(jax.random.uniform(next(ks), shape, f32, 1.0, 16.0))

    d = D_MODEL
    return {
        "x": nrm((BATCH, SEQ, d), 1.0),
        "c": nrm((BATCH, d), 1.0),
        "rel_bias": nrm((REL_BUCKETS, ATTN_HEADS), 0.5),
        "ev_ada_w": nrm((N_EVEN, d, 6 * d), 0.5 * d ** -0.5),
        "ev_ada_b": nrm((N_EVEN, 6 * d), 0.02),
        "ev_norm1_w": gain((N_EVEN, d)),
        "ev_in_w": nrm((N_EVEN, d, MIX_IN_WIDTH), d ** -0.5),
        "ev_q_norm_w": gain((N_EVEN, HEAD_DIM)),
        "ev_k_norm_w": gain((N_EVEN, HEAD_DIM)),
        "ev_sink": nrm((N_EVEN, ATTN_HEADS), 0.5),
        "ev_out_w": nrm((N_EVEN, MIX_OUT_WIDTH, d), MIX_OUT_WIDTH ** -0.5),
        "ev_norm2_w": gain((N_EVEN, d)),
        "ev_ffn_w1": nrm((N_EVEN, d, D_FF), d ** -0.5),
        "ev_ffn_w3": nrm((N_EVEN, d, D_FF), d ** -0.5),
        "ev_ffn_w2": nrm((N_EVEN, D_FF, d), D_FF ** -0.5),
        "od_ada_w": nrm((N_ODD, d, 6 * d), 0.5 * d ** -0.5),
        "od_ada_b": nrm((N_ODD, 6 * d), 0.02),
        "od_norm1_w": gain((N_ODD, d)),
        "od_in_w": nrm((N_ODD, d, SSM_IN_WIDTH), d ** -0.5),
        "od_conv_w": nrm((N_ODD, CONV_WIDTH, CONV_DIM), CONV_WIDTH ** -0.5),
        "od_conv_b": nrm((N_ODD, CONV_DIM), 0.02),
        "od_dt_bias_f": dt_bias((N_ODD, SSM_HEADS)),
        "od_dt_bias_b": dt_bias((N_ODD, SSM_HEADS)),
        "od_A_log_f": a_log((N_ODD, SSM_HEADS)),
        "od_A_log_b": a_log((N_ODD, SSM_HEADS)),
        "od_D": gain((N_ODD, SSM_HEADS)),
        "od_gnorm_w": gain((N_ODD, D_INNER)),
        "od_out_w": nrm((N_ODD, D_INNER, d), D_INNER ** -0.5),
        "od_norm2_w": gain((N_ODD, d)),
        "od_router_w": nrm((N_ODD, d, N_EXPERTS), d ** -0.5),
        "od_router_b": nrm((N_ODD, N_EXPERTS), 0.01),
        "od_moe_w1": nrm((N_ODD, N_EXPERTS, d, D_FF_EXPERT), d ** -0.5),
        "od_moe_w3": nrm((N_ODD, N_EXPERTS, d, D_FF_EXPERT), d ** -0.5),
        "od_moe_w2": nrm((N_ODD, N_EXPERTS, D_FF_EXPERT, d), D_FF_EXPERT ** -0.5),
    }


def reference(x, c, rel_bias,
              ev_ada_w, ev_ada_b, ev_norm1_w, ev_in_w, ev_q_norm_w, ev_k_norm_w, ev_sink,
              ev_out_w, ev_norm2_w, ev_ffn_w1, ev_ffn_w3, ev_ffn_w2,
              od_ada_w, od_ada_b, od_norm1_w, od_in_w, od_conv_w, od_conv_b,
              od_dt_bias_f, od_dt_bias_b, od_A_log_f, od_A_log_b, od_D, od_gnorm_w, od_out_w,
              od_norm2_w, od_router_w, od_router_b, od_moe_w1, od_moe_w3, od_moe_w2):
    cs = jax.nn.silu(c)
    for i in range(DEPTH):
        j = i // 2
        if i % 2 == 0:
            mod = cs @ ev_ada_w[j] + ev_ada_b[j]
            sh1, sc1, g1, sh2, sc2, g2 = jnp.split(mod, 6, axis=-1)
            hm = even_mixer(modulate(x, ev_norm1_w[j], sh1, sc1), ev_in_w[j], ev_q_norm_w[j],
                            ev_k_norm_w[j], ev_sink[j], ev_out_w[j], rel_bias)
            x = x + g1[:, None, :] * hm
            hf = swiglu(modulate(x, ev_norm2_w[j], sh2, sc2), ev_ffn_w1[j], ev_ffn_w3[j], ev_ffn_w2[j])
            x = x + g2[:, None, :] * hf
        else:
            mod = cs @ od_ada_w[j] + od_ada_b[j]
            sh1, sc1, g1, sh2, sc2, g2 = jnp.split(mod, 6, axis=-1)
            hm = ssd_mixer(modulate(x, od_norm1_w[j], sh1, sc1), od_in_w[j], od_conv_w[j], od_conv_b[j],
                           od_dt_bias_f[j], od_dt_bias_b[j], od_A_log_f[j], od_A_log_b[j], od_D[j],
                           od_gnorm_w[j], od_out_w[j])
            x = x + g1[:, None, :] * hm
            hf = moe_swiglu(modulate(x, od_norm2_w[j], sh2, sc2), od_router_w[j], od_router_b[j],
                            od_moe_w1[j], od_moe_w3[j], od_moe_w2[j])
            x = x + g2[:, None, :] * hf
    return x
```

```cpp
#include <hip/hip_runtime.h>
#include <stdint.h>

#ifndef MK_N_LAUNCHES
#define MK_N_LAUNCHES 1
#endif

#define LAS __attribute__((address_space(3)))
#define GAS __attribute__((address_space(1)))
typedef unsigned short bf16;
typedef short bf16x8 __attribute__((ext_vector_type(8)));
typedef float f32x4 __attribute__((ext_vector_type(4)));
typedef float f32x16 __attribute__((ext_vector_type(16)));
typedef unsigned u32x4 __attribute__((ext_vector_type(4)));
typedef unsigned u32x2 __attribute__((ext_vector_type(2)));

constexpr int D = 1024, NBATCH = 8, SEQ = 2048, T = NBATCH * SEQ;
constexpr int DFF = 2816, DI = 2048, CDIM = 3072, NHEAD_SSM = 32, NEXP = 8, DFE = 3584;
constexpr int QKVW = 768;
constexpr int MAXPAN = 136;
constexpr float EPS = 1e-6f;

constexpr size_t MiB = 1u << 20;
constexpr size_t WS_CTL = 0, CTL_ZERO_BYTES = 1 * MiB;
constexpr size_t WS_MODP = 1 * MiB;
constexpr size_t WS_MOD = 7 * MiB;
constexpr size_t WS_ROUTE = 7 * MiB + 512 * 1024;
constexpr size_t WS_WM13 = 9 * MiB;
constexpr size_t WS_WM2 = 121 * MiB;
constexpr size_t WS_WU = 177 * MiB;
constexpr size_t WS_WQKV = 179 * MiB;
constexpr size_t WS_WO0 = 181 * MiB;
constexpr size_t WS_WF13 = 183 * MiB;
constexpr size_t WS_WF2 = 194 * MiB;
constexpr size_t WS_WSIN = 200 * MiB;
constexpr size_t WS_WSOUT = 211 * MiB;
constexpr size_t WS_FDFT = 215 * MiB;
constexpr size_t WS_ACT = 231 * MiB;
constexpr size_t WS_XN = WS_ACT;
constexpr size_t WS_UT = WS_ACT + 32 * MiB;
constexpr size_t WS_QKV = WS_ACT + 64 * MiB;
constexpr size_t WS_Y0 = WS_ACT + 88 * MiB;
constexpr size_t WS_H0 = WS_ACT + 120 * MiB;
constexpr size_t WS_Z = WS_ACT + 32 * MiB;
constexpr size_t WS_XBC = WS_ACT + 96 * MiB;
constexpr size_t WS_DT = WS_ACT + 192 * MiB;
constexpr size_t WS_YM = WS_ACT + 196 * MiB;
constexpr size_t WS_YN = WS_XBC;
constexpr size_t WS_HP = 177 * MiB;
constexpr size_t WS_AP = 415 * MiB;
constexpr size_t WS_END = 483 * MiB;
constexpr size_t RT_TOKE = 0;
constexpr size_t RT_TOKP = 131072;
constexpr size_t RT_TOKW = 262144;
constexpr size_t RT_ROWTOK = 393216;
constexpr size_t RT_ROWW = 393216 + 139264;
constexpr int CW_BAR = 4096;
constexpr int CW_GCNT = 16384;

constexpr int LDS_BYTES = 163840 - 512;
constexpr int MISC_OFF = 160000;

__device__ __forceinline__ unsigned pk2(float lo, float hi) { unsigned r; asm volatile("v_cvt_pk_bf16_f32 %0, %1, %2" : "=v"(r) : "v"(lo), "v"(hi)); return r; }
__device__ __forceinline__ float bflo(unsigned u) { return __uint_as_float(u << 16); }
__device__ __forceinline__ float bfhi(unsigned u) { return __uint_as_float(u & 0xffff0000u); }
__device__ __forceinline__ float bf1(bf16 b) { return __uint_as_float(((unsigned)b) << 16); }
__device__ __forceinline__ float siluf(float x) { return x / (1.0f + __expf(-x)); }
__device__ __forceinline__ float wave_sum(float v) {
#pragma unroll
    for (int o = 1; o < 64; o <<= 1) v += __shfl_xor(v, o);
    return v;
}
#define LDS_WAIT() asm volatile("s_waitcnt lgkmcnt(0)" ::: "memory")
#define VM_WAIT() asm volatile("s_waitcnt vmcnt(0)" ::: "memory")

namespace pg8 {
constexpr int BM = 256, BK = 64, HALF = 128, HTB = HALF * BK * 2, STAGE_BYTES = 8 * HTB, NXCD = 8, WGM = 8;
__host__ __device__ __forceinline__ int lds_byte(int r, int c) { const int st = (r >> 4) * 2 + (c >> 5), rr = r & 15, cc = c & 31, ob = rr * 64 + cc * 2; return st * 1024 + (ob ^ (((ob >> 9) & 1) << 5)); }
__host__ __device__ __forceinline__ void stage_rc(int b, int& R, int& C) { const int st = b / 1024, sb = b % 1024, swz = sb ^ (((sb >> 9) & 1) << 5); R = (st >> 1) * 16 + swz / 64; C = (st & 1) * 32 + (swz % 64) / 2; }
__host__ __device__ __forceinline__ int perm32(int rho) { const int n = rho >> 4, i = rho & 15; return 8 * (i >> 2) + 4 * n + (i & 3); }

struct Unit { const char* a; const char* b; int pm, pn; };

__device__ __forceinline__ bool tile_order(int i, int G, int c, int nM, int nN, int& pm, int& pn) {
    const int nwg = nM * nN; const long L = (long)i * G + c; if (L >= nwg) return false;
    int wgid = (int)L; { const int q = nwg / NXCD, r = nwg % NXCD, xcd = wgid % NXCD, off = wgid / NXCD; wgid = (xcd < r ? xcd * (q + 1) : r * (q + 1) + (xcd - r) * q) + off; }
    const int nig = WGM * nN, gid = wgid / nig, fm = gid * WGM, gsz = (nM - fm) < WGM ? (nM - fm) : WGM;
    pm = fm + ((wgid % nig) % gsz); pn = (wgid % nig) / gsz; return true;
}

template <class Epi, class Sched>
__device__ __forceinline__ void gemm_phase(LAS unsigned char* lds, const int K, const Sched& S, const Epi& E) {
    const int tid = threadIdx.x, wid = __builtin_amdgcn_readfirstlane(tid >> 6), lane = tid & 63, wr = wid >> 2, wc = wid & 3, fr = lane & 15, fq = lane >> 4;
    const int nt = K / BK;
    unsigned voffA[2], voffB[2];
#pragma unroll
    for (int i = 0; i < 2; ++i) { int R, C; stage_rc(tid * 16 + i * 8192, R, C); const int Rb = Epi::PERM ? ((R & ~31) + perm32(R & 31)) : R;
        voffA[i] = (unsigned)(R * K + C) * 2u; voffB[i] = (unsigned)(Rb * K + C) * 2u; }
    const size_t kstep = (size_t)(BK * 2);
    const size_t hstep = (size_t)HALF * K * 2;
    const unsigned ldsw = (unsigned)wid * 1024u;
    const int aoff = lds_byte(wr * 64 + fr, fq * 8), boff = lds_byte(wc * 32 + fr, fq * 8);
#define PG8_SA(b, h) (((b) * 2 + (h)) * HTB)
#define PG8_SB(b, h) ((4 + (b) * 2 + (h)) * HTB)
#define PG8_STAGE(bufoff, gbase, voff) do { _Pragma("unroll") for (int _i = 0; _i < 2; ++_i) \
        __builtin_amdgcn_global_load_lds((const unsigned*)((const char*)(gbase) + (voff)[_i]), (LAS unsigned*)(lds + (bufoff) + ldsw + _i * 8192), 16, 0, 0); } while (0)
#define PG8_LDA(dst, b, h) do { _Pragma("unroll") for (int m = 0; m < 4; ++m) _Pragma("unroll") for (int k = 0; k < 2; ++k) dst[m][k] = *(const LAS bf16x8*)(lds + PG8_SA(b, h) + aoff + m * 2048 + k * 1024); } while (0)
#define PG8_LDB(dst, b, h) do { _Pragma("unroll") for (int n = 0; n < 2; ++n) _Pragma("unroll") for (int k = 0; k < 2; ++k) dst[n][k] = *(const LAS bf16x8*)(lds + PG8_SB(b, h) + boff + n * 2048 + k * 1024); } while (0)
#define PG8_MMA(ai, bj, At, Bt) do { __builtin_amdgcn_s_setprio(1); _Pragma("unroll") for (int m = 0; m < 4; ++m) _Pragma("unroll") for (int n = 0; n < 2; ++n) _Pragma("unroll") for (int k = 0; k < 2; ++k) \
        acc[ai][bj][m][n] = __builtin_amdgcn_mfma_f32_16x16x32_bf16(Bt[n][k], At[m][k], acc[ai][bj][m][n], 0, 0, 0); __builtin_amdgcn_s_setprio(0); } while (0)
#define PG8_WAIT_V(n) asm volatile("s_waitcnt vmcnt(" #n ")" ::: "memory")
#define PG8_WAIT_L(n) asm volatile("s_waitcnt lgkmcnt(" #n ")" ::: "memory")
#define PG8_BAR __builtin_amdgcn_s_barrier()
#define PG8_SCHED __builtin_amdgcn_sched_barrier(0)
    Unit cur, nxt; int ui = 0;
    if (!S.next(0, cur)) return;
    f32x4 acc[2][2][4][2];
#pragma unroll
    for (int a = 0; a < 2; ++a)
#pragma unroll
        for (int b = 0; b < 2; ++b)
#pragma unroll
            for (int m = 0; m < 4; ++m)
#pragma unroll
                for (int n = 0; n < 2; ++n) acc[a][b][m][n] = (f32x4){0.f, 0.f, 0.f, 0.f};
    bf16x8 At[4][2], B0[2][2], B1[2][2];
    const char* cA = cur.a; const char* cB = cur.b;
    PG8_STAGE(PG8_SB(0, 0), cB, voffB); PG8_STAGE(PG8_SB(0, 1), cB + hstep, voffB); PG8_STAGE(PG8_SA(0, 0), cA, voffA); PG8_STAGE(PG8_SA(0, 1), cA + hstep, voffA);
    if (wr == 1) PG8_BAR;
    PG8_WAIT_V(2); PG8_BAR;
    PG8_STAGE(PG8_SB(1, 0), cB + kstep, voffB); PG8_STAGE(PG8_SA(1, 0), cA + kstep, voffA); PG8_STAGE(PG8_SB(1, 1), cB + hstep + kstep, voffB);
    PG8_WAIT_V(6); PG8_BAR;
    for (;;) {
        const bool has_next = S.next(ui + 1, nxt);
        const char* nA = has_next ? nxt.a : cA; const char* nB = has_next ? nxt.b : cB;
        for (int t = 0; t < nt; t += 2) {
            const bool last = (t == nt - 2);
            const char* a1 = cA + (size_t)(t + 1) * kstep;
            const char* a2 = last ? nA : cA + (size_t)(t + 2) * kstep; const char* b2 = last ? nB : cB + (size_t)(t + 2) * kstep;
            const char* a3 = a2 + kstep; const char* b3 = b2 + kstep;
            PG8_LDB(B0, 0, 0); PG8_LDB(B1, 0, 1); PG8_SCHED; PG8_LDA(At, 0, 0); PG8_STAGE(PG8_SA(1, 1), a1 + hstep, voffA);
            PG8_WAIT_V(8); PG8_WAIT_L(0); PG8_BAR; PG8_MMA(0, 0, At, B0); PG8_MMA(0, 1, At, B1); PG8_BAR; PG8_SCHED;
            PG8_LDA(At, 0, 1); PG8_STAGE(PG8_SB(0, 0), b2, voffB); PG8_STAGE(PG8_SB(0, 1), b2 + hstep, voffB); PG8_STAGE(PG8_SA(0, 0), a2, voffA);
            PG8_WAIT_V(8); PG8_WAIT_L(0); PG8_BAR; PG8_MMA(1, 0, At, B0); PG8_MMA(1, 1, At, B1); PG8_BAR; PG8_SCHED;
            PG8_LDB(B0, 1, 0); PG8_LDB(B1, 1, 1); PG8_SCHED; PG8_LDA(At, 1, 0); PG8_STAGE(PG8_SA(0, 1), a2 + hstep, voffA);
            PG8_WAIT_V(8); PG8_WAIT_L(0); PG8_BAR; PG8_MMA(0, 0, At, B0); PG8_MMA(0, 1, At, B1); PG8_BAR; PG8_SCHED;
            PG8_LDA(At, 1, 1); PG8_STAGE(PG8_SB(1, 0), b3, voffB); PG8_STAGE(PG8_SB(1, 1), b3 + hstep, voffB); PG8_STAGE(PG8_SA(1, 0), a3, voffA);
            PG8_WAIT_V(8); PG8_WAIT_L(0); PG8_BAR; PG8_MMA(1, 0, At, B0); PG8_MMA(1, 1, At, B1); PG8_BAR; PG8_SCHED;
        }
        if (wr == 0) PG8_BAR;
        E(acc, cur, wr, wc, fr, fq);
        if (!has_next) break;
#pragma unroll
        for (int a = 0; a < 2; ++a)
#pragma unroll
            for (int b = 0; b < 2; ++b)
#pragma unroll
                for (int m = 0; m < 4; ++m)
#pragma unroll
                    for (int n = 0; n < 2; ++n) acc[a][b][m][n] = (f32x4){0.f, 0.f, 0.f, 0.f};
        cur = nxt; cA = nA; cB = nB; ++ui;
        if (wr == 1) PG8_BAR;
    }
    PG8_WAIT_V(0);
    PG8_BAR;
#undef PG8_SA
#undef PG8_SB
#undef PG8_STAGE
#undef PG8_LDA
#undef PG8_LDB
#undef PG8_MMA
#undef PG8_WAIT_V
#undef PG8_WAIT_L
#undef PG8_BAR
#undef PG8_SCHED
}
}
using pg8::Unit;

#define XB_TMO      128
#define XB_XCNT(j)  (256  + 64 * (j))
#define XB_XSUB(j)  (1280 + 64 * (j))
#define XB_XGEN(j)  (2304 + 64 * (j))
#define XB_TOP      3328
#define XB_TOPGEN   3392
#define XCD_BAR_WORDS 3456
#define XB_SPIN_CAP (1u << 18)
__device__ __forceinline__ unsigned xb_ld(unsigned* p)              { return __hip_atomic_load(p, __ATOMIC_RELAXED, __HIP_MEMORY_SCOPE_AGENT); }
__device__ __forceinline__ unsigned xb_add(unsigned* p, unsigned v) { return __hip_atomic_fetch_add(p, v, __ATOMIC_RELAXED, __HIP_MEMORY_SCOPE_AGENT); }
__device__ __forceinline__ unsigned xb_xcc_id() { return (unsigned)__builtin_amdgcn_s_getreg((3 << 11) | 20) & 0xFu; }
#define XB_SPIN(cond, bar) do { unsigned _sp = 0; while (cond) { __builtin_amdgcn_s_sleep(1); \
    if ((++_sp & 255u) == 0u) { if (xb_ld(&(bar)[XB_TMO])) break; if (_sp > XB_SPIN_CAP) { atomicAdd(&(bar)[XB_TMO], 1u); break; } } } } while (0)
struct XcdBarrier { unsigned* bar; unsigned x; volatile LAS unsigned* st; };
__device__ __forceinline__ XcdBarrier xcd_barrier_post(unsigned* bar, volatile LAS unsigned* st) {
    XcdBarrier b; b.bar = bar; b.x = xb_xcc_id(); b.st = st;
    if (threadIdx.x == 0) (void)xb_add(&bar[XB_XCNT(b.x)], 1u);
    return b;
}
__device__ __forceinline__ void xcd_barrier_complete(unsigned* bar, unsigned x, unsigned& nloc, unsigned& nx) {
    const unsigned G = gridDim.x * gridDim.y * gridDim.z;
    unsigned sum, cnt, mine, sp = 0u;
    for (;;) {
        sum = 0u; cnt = 0u; mine = 0u;
#pragma unroll
        for (unsigned j = 0; j < 16; ++j) { const unsigned c = xb_ld(&bar[XB_XCNT(j)]); sum += c; cnt += (c > 0u) ? 1u : 0u; mine = (j == x) ? c : mine; }
        if (sum == G) break;
        __builtin_amdgcn_s_sleep(1);
        if ((++sp & 255u) == 0u) { if (xb_ld(&bar[XB_TMO])) break; if (sp > XB_SPIN_CAP) { atomicAdd(&bar[XB_TMO], 1u); break; } }
    }
    nloc = mine > 0u ? mine : 1u; nx = cnt > 0u ? cnt : 1u;
}
__device__ __forceinline__ void xcd_barrier(const XcdBarrier& b) {
    asm volatile("s_waitcnt vmcnt(0)" ::: "memory");
    __syncthreads();
    if (threadIdx.x == 0) {
        unsigned* bar = b.bar;
        __builtin_amdgcn_s_waitcnt(0);
        unsigned nloc = b.st[0], nx = b.st[1];
        if (nloc == 0u) { xcd_barrier_complete(bar, b.x, nloc, nx); b.st[0] = nloc; b.st[1] = nx; }
        const unsigned old = xb_add(&bar[XB_XSUB(b.x)], 1u);
        const unsigned gen = old / nloc;
        if (old + 1u == (gen + 1u) * nloc) {
            __builtin_amdgcn_fence(__ATOMIC_RELEASE, "agent");
            asm volatile("s_waitcnt vmcnt(0)" ::: "memory");
            const unsigned og = xb_add(&bar[XB_TOP], 1u);
            const unsigned tg = og / nx;
            if (og + 1u == (tg + 1u) * nx) xb_add(&bar[XB_TOPGEN], 1u);
            else XB_SPIN(xb_ld(&bar[XB_TOPGEN]) == tg, bar);
            __builtin_amdgcn_fence(__ATOMIC_ACQUIRE, "agent");
            xb_add(&bar[XB_XGEN(b.x)], 1u);
            asm volatile("s_waitcnt vmcnt(0)" ::: "memory");
        } else {
            XB_SPIN(xb_ld(&bar[XB_XGEN(b.x)]) == gen, bar);
            __builtin_amdgcn_fence(__ATOMIC_ACQUIRE, "agent");
            asm volatile("s_waitcnt vmcnt(0)" ::: "memory");
        }
    }
    __syncthreads();
}

struct Args {
    const float* in[34];
    float* out;
    unsigned char* ws;
    int ph_lo, ph_hi;
};

enum { I_X = 0, I_C, I_RELB, I_EADAW, I_EADAB, I_EN1, I_EINW, I_EQN, I_EKN, I_ESINK, I_EOUTW, I_EN2, I_EF1, I_EF3, I_EF2,
       I_OADAW, I_OADAB, I_ON1, I_OINW, I_OCONVW, I_OCONVB, I_ODTBF, I_ODTBB, I_OALF, I_OALB, I_OD, I_OGN, I_OOUTW, I_ON2, I_ORW, I_ORB, I_OM1, I_OM3, I_OM2 };

struct Frame {
    LAS unsigned char* lds;
    unsigned char* ws;
    int tid, lane, wave, G, vcu;
};

__device__ __forceinline__ void tr_item(const float* src  , int srcN, int k0, int n0, bf16* dstrow  , int dstK, LAS float* scr, int lane) {
#pragma unroll 8
    for (int i = 0; i < 32; ++i) { const int kk = 2 * i + (lane >> 5); scr[kk * 33 + (lane & 31)] = src[(size_t)(k0 + kk) * srcN + n0 + (lane & 31)]; }
    LDS_WAIT(); asm volatile("" ::: "memory");
    const int c = lane & 7;
#pragma unroll
    for (int j = 0; j < 4; ++j) { const int n = (lane >> 3) + 8 * j; const LAS float* s = scr + (8 * c) * 33 + n;
        u32x4 o; o.x = pk2(s[0 * 33], s[1 * 33]); o.y = pk2(s[2 * 33], s[3 * 33]); o.z = pk2(s[4 * 33], s[5 * 33]); o.w = pk2(s[6 * 33], s[7 * 33]);
        *(u32x4*)(dstrow + (size_t)n * dstK + k0 + 8 * c) = o; }
    LDS_WAIT(); asm volatile("" ::: "memory");
}

__device__ __forceinline__ void p0_prologue(const Frame& F, const Args& A) {
    const int tid = F.tid, lane = F.lane, wave = F.wave;
    unsigned char* ws = F.ws;
    if (blockIdx.x < 128) {
        const int it = blockIdx.x, kb = it & 15, part = (it >> 4) & 1, g = it >> 5;
        LAS float* tile = (LAS float*)F.lds;
        LAS float* ctab = (LAS float*)(F.lds + 32768);
        const float* Win = A.in[I_EINW];
        for (int i = tid; i < 64 * 128; i += 512) { const int kk = i >> 7, c = i & 127; tile[i] = Win[(size_t)(kb * 64 + kk) * 1280 + g * 128 + c]; }
        if (tid < 128) { const float ang = (float)tid * (6.283185307179586f / 128.0f); ctab[tid] = (part ? sinf(ang) : cosf(ang)) * 0.08838834764831845f; }
        __syncthreads();
        const int m = tid & 127, kq = tid >> 7;
        float accv[16];
#pragma unroll
        for (int j = 0; j < 16; ++j) accv[j] = 0.f;
        for (int c = 0; c < 128; ++c) { const float w = ctab[(m * c) & 127];
#pragma unroll
            for (int j = 0; j < 16; ++j) accv[j] += tile[(kq * 16 + j) * 128 + c] * w; }
        bf16* WU = (bf16*)(ws + WS_WU);
        u32x4 o0, o1;
        o0.x = pk2(accv[0], accv[1]); o0.y = pk2(accv[2], accv[3]); o0.z = pk2(accv[4], accv[5]); o0.w = pk2(accv[6], accv[7]);
        o1.x = pk2(accv[8], accv[9]); o1.y = pk2(accv[10], accv[11]); o1.z = pk2(accv[12], accv[13]); o1.w = pk2(accv[14], accv[15]);
        bf16* dst = WU + (size_t)(part * 512 + g * 128 + m) * 1024 + kb * 64 + kq * 16;
        *(u32x4*)dst = o0; *(u32x4*)(dst + 8) = o1;
        __syncthreads();
    }
    {
        LAS float* ct = (LAS float*)F.lds;
        for (int j = tid; j < 2048; j += 512) ct[j] = cosf((float)j * (6.283185307179586f / 2048.0f)) * 0.022097086912079608f;
        __syncthreads();
        bf16* FD = (bf16*)(ws + WS_FDFT);
        const int nchunk = 2048 * 4096 / 8;
        for (int ch = blockIdx.x * 512 + tid; ch < nchunk; ch += F.G * 512) {
            const int k = ch >> 9, c0 = (ch & 511) * 8;
            float v[8];
#pragma unroll
            for (int e = 0; e < 8; ++e) { const int cc = c0 + e; if (cc < 2048) v[e] = ct[(k * cc) & 2047]; else v[e] = -ct[((k * (cc - 2048)) - 512) & 2047]; }
            u32x4 o; o.x = pk2(v[0], v[1]); o.y = pk2(v[2], v[3]); o.z = pk2(v[4], v[5]); o.w = pk2(v[6], v[7]);
            *(u32x4*)(FD + (size_t)k * 4096 + c0) = o;
        }
        __syncthreads();
    }
    const int gw = F.vcu * 8 + wave, NGW = F.G * 8;
    {
        float* MODP = (float*)(ws + WS_MODP);
        for (int it = gw; it < 192 * 16; it += NGW) {
            const int cg = it % 192, ks = it / 192, l = cg / 96, col = (cg % 96) * 64 + lane;
            const float* W = A.in[l ? I_OADAW : I_EADAW];
            float cs[8], acc8[8];
#pragma unroll
            for (int b = 0; b < 8; ++b) { cs[b] = siluf(A.in[I_C][b * 1024 + ks * 64 + lane]); acc8[b] = 0.f; }
#pragma unroll 8
            for (int kk = 0; kk < 64; ++kk) { const float w = W[(size_t)(ks * 64 + kk) * 6144 + col];
#pragma unroll
                for (int b = 0; b < 8; ++b) acc8[b] += __shfl(cs[b], kk) * w; }
#pragma unroll
            for (int b = 0; b < 8; ++b) MODP[(size_t)ks * 98304 + l * 49152 + b * 6144 + col] = acc8[b];
        }
    }
    {
        LAS float* scr = (LAS float*)(F.lds + wave * 16384);
        constexpr int N1 = 16 * 24, N2 = 16 * 32, N3 = 16 * 88, N5 = 44 * 32, N6 = 16 * 162, N7 = 32 * 32, N8 = 8 * 16 * 112, N10 = 8 * 56 * 32;
        constexpr int NIT = N1 + N2 + 2 * N3 + N5 + N6 + N7 + 2 * N8 + N10;
        for (int it = gw; it < NIT; it += NGW) {
            int r = it;
            if (r < N1) { const int kb = r / 24, nb = r % 24; tr_item(A.in[I_EINW] + 512, 1280, kb * 64, nb * 32, (bf16*)(ws + WS_WQKV) + (size_t)(nb * 32) * 1024, 1024, scr, lane); continue; } r -= N1;
            if (r < N2) { const int kb = r / 32, nb = r % 32; tr_item(A.in[I_EOUTW], 1024, kb * 64, nb * 32, (bf16*)(ws + WS_WO0) + (size_t)(nb * 32) * 1024, 1024, scr, lane); continue; } r -= N2;
            if (r < 2 * N3) { const int w3 = r >= N3; if (w3) r -= N3; const int kb = r / 88, nb = r % 88, n0 = nb * 32, drow = (n0 >> 7) * 256 + (n0 & 127) + (w3 ? 128 : 0);
                tr_item(A.in[w3 ? I_EF3 : I_EF1], DFF, kb * 64, n0, (bf16*)(ws + WS_WF13) + (size_t)drow * 1024, 1024, scr, lane); continue; } r -= 2 * N3;
            if (r < N5) { const int kb = r / 32, nb = r % 32; tr_item(A.in[I_EF2], 1024, kb * 64, nb * 32, (bf16*)(ws + WS_WF2) + (size_t)(nb * 32) * DFF, DFF, scr, lane); continue; } r -= N5;
            if (r < N6) { const int kb = r / 162, nb = r % 162; tr_item(A.in[I_OINW], 5184, kb * 64, nb * 32, (bf16*)(ws + WS_WSIN) + (size_t)(nb * 32) * 1024, 1024, scr, lane); continue; } r -= N6;
            if (r < N7) { const int kb = r / 32, nb = r % 32; tr_item(A.in[I_OOUTW], 1024, kb * 64, nb * 32, (bf16*)(ws + WS_WSOUT) + (size_t)(nb * 32) * 2048, 2048, scr, lane); continue; } r -= N7;
            if (r < 2 * N8) { const int w3 = r >= N8; if (w3) r -= N8; const int e = r / (16 * 112); r %= 16 * 112; const int kb = r / 112, nb = r % 112, n0 = nb * 32, drow = (n0 >> 7) * 256 + (n0 & 127) + (w3 ? 128 : 0);
                tr_item(A.in[w3 ? I_OM3 : I_OM1] + (size_t)e * 1024 * DFE, DFE, kb * 64, n0, (bf16*)(ws + WS_WM13) + ((size_t)e * 7168 + drow) * 1024, 1024, scr, lane); continue; } r -= 2 * N8;
            { const int e = r / (56 * 32); r %= 56 * 32; const int kb = r / 32, nb = r % 32;
                tr_item(A.in[I_OM2] + (size_t)e * DFE * 1024, 1024, kb * 64, nb * 32, (bf16*)(ws + WS_WM2) + ((size_t)e * 1024 + nb * 32) * DFE, DFE, scr, lane); }
        }
    }
}

template <int MODE>
__device__ __forceinline__ void modulate_phase(const Frame& F, const Args& A, const float* xsrc, const float* normw, int layer, int which  ) {
    const int tid = F.tid, lane = F.lane, wave = F.wave;
    unsigned char* ws = F.ws;
    LAS float* sh = (LAS float*)F.lds;
    LAS float* sc = sh + 1024;
    LAS float* nw = sc + 1024;
    LAS float* rw = nw + 1024;
    LAS int* lcnt = (LAS int*)(rw + 8192);
    LAS int* gbase = lcnt + 8;
    LAS int* sel_e = gbase + 8;
    LAS int* sel_p = sel_e + 128;
    LAS float* sel_w = (LAS float*)(sel_p + 128);
    const float* MODP = (const float*)(ws + WS_MODP);
    float* MOD = (float*)(ws + WS_MOD);
    bf16* XN = (bf16*)(ws + WS_XN);
    for (int blk = blockIdx.x; blk < T / 64; blk += F.G) {
        const int row0 = blk * 64, b = row0 / SEQ;
        __syncthreads();
        for (int i = tid; i < 2048; i += 512) {
            const int idx = layer * 49152 + b * 6144 + which * 3072 + i;
            float v;
            if (MODE == 0) { v = A.in[I_EADAB][which * 3072 + i];
#pragma unroll
                for (int ks = 0; ks < 16; ++ks) v += MODP[(size_t)ks * 98304 + idx]; }
            else v = MOD[idx];
            sh[i] = v;
        }
        for (int i = tid; i < 1024; i += 512) nw[i] = normw[i];
        if (MODE == 2) { for (int i = tid; i < 8192; i += 512) { const int e = i >> 10, c = i & 1023; rw[i] = A.in[I_ORW][c * 8 + e]; } if (tid < 8) lcnt[tid] = 0; }
        __syncthreads();
        for (int rr = 0; rr < 8; ++rr) {
            const int lr = wave * 8 + rr, row = row0 + lr;
            const GAS f32x4* xr = (const GAS f32x4*)(xsrc + (size_t)row * D) + lane;
            f32x4 v[4]; float ss = 0.f;
#pragma unroll
            for (int j = 0; j < 4; ++j) { v[j] = xr[64 * j]; ss += (v[j].x * v[j].x + v[j].y * v[j].y) + (v[j].z * v[j].z + v[j].w * v[j].w); }
            const float rstd = 1.0f / sqrtf(wave_sum(ss) * (1.0f / D) + EPS);
            GAS unsigned long long* o8 = (GAS unsigned long long*)(XN + (size_t)row * D) + lane;
            float lg[8];
            if (MODE == 2) {
#pragma unroll
                for (int e = 0; e < 8; ++e) lg[e] = 0.f; }
#pragma unroll
            for (int j = 0; j < 4; ++j) {
                const int c = 4 * lane + 256 * j;
                const f32x4 w4 = *(const LAS f32x4*)(nw + c), s4 = *(const LAS f32x4*)(sc + c), h4 = *(const LAS f32x4*)(sh + c);
                f32x4 y;
                y.x = v[j].x * rstd * w4.x * (1.0f + s4.x) + h4.x; y.y = v[j].y * rstd * w4.y * (1.0f + s4.y) + h4.y;
                y.z = v[j].z * rstd * w4.z * (1.0f + s4.z) + h4.z; y.w = v[j].w * rstd * w4.w * (1.0f + s4.w) + h4.w;
                o8[64 * j] = (unsigned long long)pk2(y.x, y.y) | ((unsigned long long)pk2(y.z, y.w) << 32);
                if (MODE == 2) {
#pragma unroll
                    for (int e = 0; e < 8; ++e) { const f32x4 r4 = *(const LAS f32x4*)(rw + e * 1024 + c); lg[e] += (y.x * r4.x + y.y * r4.y) + (y.z * r4.z + y.w * r4.w); } }
            }
            if (MODE == 2) {
#pragma unroll
                for (int e = 0; e < 8; ++e) lg[e] = wave_sum(lg[e]) + A.in[I_ORB][e];
                int i0 = 0; float v0 = lg[0];
#pragma unroll
                for (int e = 1; e < 8; ++e) if (lg[e] > v0) { v0 = lg[e]; i0 = e; }
                int i1 = -1; float v1 = -3.0e38f;
#pragma unroll
                for (int e = 0; e < 8; ++e) if (e != i0 && lg[e] > v1) { v1 = lg[e]; i1 = e; }
                const float w0 = 1.0f / (1.0f + __expf(v1 - v0)), w1 = 1.0f - w0;
                if (lane == 0) {
                    sel_e[lr * 2] = i0; sel_e[lr * 2 + 1] = i1; sel_w[lr * 2] = w0; sel_w[lr * 2 + 1] = w1;
                    sel_p[lr * 2] = __hip_atomic_fetch_add(lcnt + i0, 1, __ATOMIC_RELAXED, __HIP_MEMORY_SCOPE_WORKGROUP);
                    sel_p[lr * 2 + 1] = __hip_atomic_fetch_add(lcnt + i1, 1, __ATOMIC_RELAXED, __HIP_MEMORY_SCOPE_WORKGROUP);
                }
            }
        }
        if (MODE == 2) {
            __syncthreads();
            unsigned* gcnt = (unsigned*)(ws + WS_CTL) + CW_GCNT;
            if (tid < 8) gbase[tid] = (int)__hip_atomic_fetch_add(gcnt + tid, (unsigned)lcnt[tid], __ATOMIC_RELAXED, __HIP_MEMORY_SCOPE_AGENT);
            __syncthreads();
            if (tid < 128) { const int tok = row0 + (tid >> 1), k = tid & 1, e = sel_e[tid];
                ((int*)(ws + WS_ROUTE + RT_TOKE))[tok * 2 + k] = e;
                ((int*)(ws + WS_ROUTE + RT_TOKP))[tok * 2 + k] = gbase[e] + sel_p[tid];
                ((float*)(ws + WS_ROUTE + RT_TOKW))[tok * 2 + k] = sel_w[tid]; }
        }
    }
    if (MODE == 0) {
        const int idx = blockIdx.x * 384 + tid;
        if (tid < 384 && idx < 98304) { const int l = idx / 49152, col = idx % 6144; float v = A.in[l ? I_OADAB : I_EADAB][col];
#pragma unroll
            for (int ks = 0; ks < 16; ++ks) v += MODP[(size_t)ks * 98304 + idx];
            MOD[idx] = v; }
    }
}

struct SchedPlain {
    const char* A; const char* B; int nM, nN, G, c; size_t tstep;
    __device__ __forceinline__ bool next(int i, Unit& u) const { int pm, pn; if (!pg8::tile_order(i, G, c, nM, nN, pm, pn)) return false; u.pm = pm; u.pn = pn; u.a = A + (size_t)pm * tstep; u.b = B + (size_t)pn * tstep; return true; }
};
struct SchedFourier {
    const char* Fm; const char* UT; int unit;
    __device__ __forceinline__ bool next(int i, Unit& u) const { if (i != 0 || unit < 0) return false; const int b = unit >> 4, idx = unit & 15; u.pm = b * 8 + (idx & 7); u.pn = idx >> 3;
        u.a = Fm + (size_t)(idx & 7) * 256 * 4096 * 2; u.b = UT + ((size_t)b * 512 + (size_t)(idx >> 3) * 256) * 4096 * 2; return true; }
};
struct SchedMoe {
    const char* A; const char* B; const LAS int* pexp; int nM, nN, G, c; size_t tstepA, tstepB; int tiles_per_exp;
    __device__ __forceinline__ bool next(int i, Unit& u) const { int pm, pn; if (!pg8::tile_order(i, G, c, nM, nN, pm, pn)) return false; u.pm = pm; u.pn = pn; const int e = pexp[pm];
        u.a = A + (size_t)pm * tstepA; u.b = B + (size_t)(e * tiles_per_exp + pn) * tstepB; return true; }
};

struct EpiBf16 {
    static constexpr bool PERM = true;
    bf16* O; int ldc;
    __device__ __forceinline__ void operator()(const f32x4 (&acc)[2][2][4][2], const Unit& u, int wr, int wc, int fr, int fq) const {
        const int row0 = u.pm * 256 + wr * 64 + fr, col0 = u.pn * 256 + wc * 32 + 8 * fq;
#pragma unroll
        for (int ai = 0; ai < 2; ++ai)
#pragma unroll
            for (int m = 0; m < 4; ++m) { bf16* rowp = O + (size_t)(row0 + ai * 128 + m * 16) * ldc + col0;
#pragma unroll
                for (int bj = 0; bj < 2; ++bj) { const f32x4 v0 = acc[ai][bj][m][0], v1 = acc[ai][bj][m][1];
                    u32x4 w; w.x = pk2(v0[0], v0[1]); w.y = pk2(v0[2], v0[3]); w.z = pk2(v1[0], v1[1]); w.w = pk2(v1[2], v1[3]);
                    *(u32x4*)(rowp + bj * 128) = w; } }
    }
};
struct EpiUT {
    static constexpr bool PERM = true;
    bf16* UT;
    __device__ __forceinline__ void operator()(const f32x4 (&acc)[2][2][4][2], const Unit& u, int wr, int wc, int fr, int fq) const {
        const int part = u.pm >> 1, c0 = (u.pm & 1) * 256 + wr * 64 + fr, b = u.pn >> 3, s0 = (u.pn & 7) * 256 + wc * 32 + 8 * fq;
        bf16* base = UT + ((size_t)b * 512) * 4096 + part * 2048 + s0;
#pragma unroll
        for (int ai = 0; ai < 2; ++ai)
#pragma unroll
            for (int m = 0; m < 4; ++m) { bf16* rowp = base + (size_t)(c0 + ai * 128 + m * 16) * 4096;
#pragma unroll
                for (int bj = 0; bj < 2; ++bj) { const f32x4 v0 = acc[ai][bj][m][0], v1 = acc[ai][bj][m][1];
                    u32x4 w; w.x = pk2(v0[0], v0[1]); w.y = pk2(v0[2], v0[3]); w.z = pk2(v1[0], v1[1]); w.w = pk2(v1[2], v1[3]);
                    *(u32x4*)(rowp + bj * 128) = w; } }
    }
};
struct EpiRes {
    static constexpr bool PERM = false;
    const float* base; float* out; const float* g;
    __device__ __forceinline__ void operator()(const f32x4 (&acc)[2][2][4][2], const Unit& u, int wr, int wc, int fr, int fq) const {
        const int row0 = u.pm * 256 + wr * 64 + fr, col0 = u.pn * 256 + wc * 32 + 4 * fq, b = (u.pm * 256) / SEQ;
        f32x4 gv[2][2];
#pragma unroll
        for (int bj = 0; bj < 2; ++bj)
#pragma unroll
            for (int n = 0; n < 2; ++n) gv[bj][n] = *(const f32x4*)(g + b * 6144 + col0 + bj * 128 + n * 16);
#pragma unroll
        for (int ai = 0; ai < 2; ++ai)
#pragma unroll
            for (int m = 0; m < 4; ++m) { const size_t off = (size_t)(row0 + ai * 128 + m * 16) * D + col0;
#pragma unroll
                for (int bj = 0; bj < 2; ++bj)
#pragma unroll
                    for (int n = 0; n < 2; ++n) { const f32x4 bs = *(const f32x4*)(base + off + bj * 128 + n * 16);
                        *(f32x4*)(out + off + bj * 128 + n * 16) = bs + gv[bj][n] * acc[ai][bj][m][n]; } }
    }
};
struct EpiSwiglu {
    static constexpr bool PERM = true;
    bf16* H; int ldc;
    __device__ __forceinline__ void operator()(const f32x4 (&acc)[2][2][4][2], const Unit& u, int wr, int wc, int fr, int fq) const {
        const int row0 = u.pm * 256 + wr * 64 + fr, col0 = u.pn * 128 + wc * 32 + 8 * fq;
#pragma unroll
        for (int ai = 0; ai < 2; ++ai)
#pragma unroll
            for (int m = 0; m < 4; ++m) { bf16* rowp = H + (size_t)(row0 + ai * 128 + m * 16) * ldc + col0;
                float h[8];
#pragma unroll
                for (int n = 0; n < 2; ++n)
#pragma unroll
                    for (int j = 0; j < 4; ++j) { const float a = acc[ai][0][m][n][j], bb = acc[ai][1][m][n][j]; h[n * 4 + j] = a / (1.0f + __expf(-a)) * bb; }
                u32x4 w; w.x = pk2(h[0], h[1]); w.y = pk2(h[2], h[3]); w.z = pk2(h[4], h[5]); w.w = pk2(h[6], h[7]);
                *(u32x4*)rowp = w; }
    }
};
struct EpiSsmIn {
    static constexpr bool PERM = true;
    bf16* Z; bf16* XBC;
    __device__ __forceinline__ void operator()(const f32x4 (&acc)[2][2][4][2], const Unit& u, int wr, int wc, int fr, int fq) const {
        const int row0 = u.pm * 256 + wr * 64 + fr; const bool isz = u.pn < 8;
        bf16* O = isz ? Z : XBC; const int ldc = isz ? 2048 : 3072, col0 = (isz ? u.pn : u.pn - 8) * 256 + wc * 32 + 8 * fq;
#pragma unroll
        for (int ai = 0; ai < 2; ++ai)
#pragma unroll
            for (int m = 0; m < 4; ++m) { bf16* rowp = O + (size_t)(row0 + ai * 128 + m * 16) * ldc + col0;
#pragma unroll
                for (int bj = 0; bj < 2; ++bj) { const f32x4 v0 = acc[ai][bj][m][0], v1 = acc[ai][bj][m][1];
                    u32x4 w; w.x = pk2(v0[0], v0[1]); w.y = pk2(v0[2], v0[3]); w.z = pk2(v1[0], v1[1]); w.w = pk2(v1[2], v1[3]);
                    *(u32x4*)(rowp + bj * 128) = w; } }
    }
};
struct EpiMoeDown {
    static constexpr bool PERM = false;
    float* out; const float* g; const int* rowtok; const float* roww;
    __device__ __forceinline__ void operator()(const f32x4 (&acc)[2][2][4][2], const Unit& u, int wr, int wc, int fr, int fq) const {
        const int row0 = u.pm * 256 + wr * 64 + fr, col0 = u.pn * 256 + wc * 32 + 4 * fq;
#pragma unroll
        for (int ai = 0; ai < 2; ++ai)
#pragma unroll
            for (int m = 0; m < 4; ++m) { const int row = row0 + ai * 128 + m * 16; const int tok = rowtok[row];
                if (tok >= 0) { const float w = roww[row]; const int b = tok / SEQ; float* orow = out + (size_t)tok * D + col0; const float* gr = g + b * 6144 + col0;
#pragma unroll
                    for (int bj = 0; bj < 2; ++bj)
#pragma unroll
                        for (int n = 0; n < 2; ++n) { const f32x4 gv = *(const f32x4*)(gr + bj * 128 + n * 16); const f32x4 a = acc[ai][bj][m][n];
#pragma unroll
                            for (int j = 0; j < 4; ++j) unsafeAtomicAdd(orow + bj * 128 + n * 16 + j, gv[j] * w * a[j]); } } }
    }
};

__device__ __forceinline__ int t5_bucket(int rel) {
    const int n = rel < 0 ? -rel : rel;
    int v = n < 8 ? n : n < 12 ? 8 : n < 16 ? 9 : n < 23 ? 10 : n < 32 ? 11 : n < 46 ? 12 : n < 64 ? 13 : n < 91 ? 14 : 15;
    return (rel > 0 ? 16 : 0) + v;
}
__device__ __forceinline__ void attn_unit(const Frame& F, const Args& A, int b, int nb, int kvh) {
    const int tid = F.tid, lane = F.lane, wave = F.wave, l31 = lane & 31, hh = lane >> 5;
    LAS bf16* Kn = (LAS bf16*)F.lds;
    LAS bf16* VT = (LAS bf16*)(F.lds + 55296);
    LAS float* btab = (LAS float*)(F.lds + 55296 + 50176);
    const bf16* QKV = (const bf16*)(F.ws + WS_QKV);
    bf16* Y = (bf16*)(F.ws + WS_Y0);
    __syncthreads();
    for (int i = 0; i < 6; ++i) {
        const int cid = tid + 512 * i, j = cid >> 3, ch = cid & 7, kpos = nb * 128 - 128 + j;
        const bool ok = kpos >= 0 && kpos < SEQ;
        u32x4 kv = (u32x4){0u, 0u, 0u, 0u}, vv = kv;
        if (ok) { const bf16* rowp = QKV + (size_t)(b * SEQ + kpos) * QKVW; kv = *(const u32x4*)(rowp + 512 + kvh * 64 + ch * 8); vv = *(const u32x4*)(rowp + 640 + kvh * 64 + ch * 8); }
        float kf[8] = {bflo(kv.x), bfhi(kv.x), bflo(kv.y), bfhi(kv.y), bflo(kv.z), bfhi(kv.z), bflo(kv.w), bfhi(kv.w)};
        float ss = 0.f;
#pragma unroll
        for (int e = 0; e < 8; ++e) ss += kf[e] * kf[e];
        ss += __shfl_xor(ss, 1); ss += __shfl_xor(ss, 2); ss += __shfl_xor(ss, 4);
        const float rstd = 1.0f / sqrtf(ss * (1.0f / 64.0f) + EPS);
        const float* kw = A.in[I_EKN] + ch * 8;
        u32x4 o; o.x = pk2(kf[0] * rstd * kw[0], kf[1] * rstd * kw[1]); o.y = pk2(kf[2] * rstd * kw[2], kf[3] * rstd * kw[3]);
        o.z = pk2(kf[4] * rstd * kw[4], kf[5] * rstd * kw[5]); o.w = pk2(kf[6] * rstd * kw[6], kf[7] * rstd * kw[7]);
        *(LAS u32x4*)(Kn + j * 72 + ch * 8) = o;
        const unsigned vw[4] = {vv.x, vv.y, vv.z, vv.w};
#pragma unroll
        for (int e = 0; e < 8; ++e) VT[(ch * 8 + e) * 392 + j] = (bf16)((e & 1) ? (vw[e >> 1] >> 16) : (vw[e >> 1] & 0xffffu));
    }
    for (int i = tid; i < 4 * 257; i += 512) { const int hq = i / 257, ri = i % 257; btab[hq * 260 + ri] = A.in[I_RELB][t5_bucket(ri - 128) * 8 + kvh * 4 + hq]; }
    __syncthreads();
    for (int itn = 0; itn < 2; ++itn) {
        const int it = wave + 8 * itn, hq = it >> 2, rb = it & 3, head = kvh * 4 + hq;
        const int qi = 32 * rb + l31, tok = b * SEQ + nb * 128 + qi;
        bf16x8 Qf[4];
        {
            u32x4 qv[4]; float ss = 0.f;
#pragma unroll
            for (int ks = 0; ks < 4; ++ks) { qv[ks] = *(const u32x4*)(QKV + (size_t)tok * QKVW + head * 64 + 16 * ks + 8 * hh);
                const unsigned w[4] = {qv[ks].x, qv[ks].y, qv[ks].z, qv[ks].w};
#pragma unroll
                for (int e = 0; e < 4; ++e) { const float a = bflo(w[e]), c = bfhi(w[e]); ss += a * a + c * c; } }
            ss += __shfl_xor(ss, 32);
            const float rstd = 0.125f / sqrtf(ss * (1.0f / 64.0f) + EPS);
#pragma unroll
            for (int ks = 0; ks < 4; ++ks) { const float* qw = A.in[I_EQN] + 16 * ks + 8 * hh; const unsigned w[4] = {qv[ks].x, qv[ks].y, qv[ks].z, qv[ks].w};
                u32x4 o; o.x = pk2(bflo(w[0]) * rstd * qw[0], bfhi(w[0]) * rstd * qw[1]); o.y = pk2(bflo(w[1]) * rstd * qw[2], bfhi(w[1]) * rstd * qw[3]);
                o.z = pk2(bflo(w[2]) * rstd * qw[4], bfhi(w[2]) * rstd * qw[5]); o.w = pk2(bflo(w[3]) * rstd * qw[6], bfhi(w[3]) * rstd * qw[7]);
                Qf[ks] = __builtin_bit_cast(bf16x8, o); }
        }
        float mrun = A.in[I_ESINK][head], lsum = hh ? 0.f : 1.0f;
        f32x16 O0, O1;
#pragma unroll
        for (int r = 0; r < 16; ++r) { O0[r] = 0.f; O1[r] = 0.f; }
        for (int tg = 0; tg < 3; ++tg) {
            f32x16 Sa[3];
#pragma unroll
            for (int kt = 0; kt < 3; ++kt) { const int jt = rb + 3 * tg + kt;
#pragma unroll
                for (int r = 0; r < 16; ++r) Sa[kt][r] = 0.f;
#pragma unroll
                for (int ks = 0; ks < 4; ++ks) { const bf16x8 kfr = *(const LAS bf16x8*)(Kn + (32 * jt + l31) * 72 + 16 * ks + 8 * hh);
                    Sa[kt] = __builtin_amdgcn_mfma_f32_32x32x16_bf16(kfr, Qf[ks], Sa[kt], 0, 0, 0); } }
            float gmax = -3.0e38f;
#pragma unroll
            for (int kt = 0; kt < 3; ++kt) { const int jt = rb + 3 * tg + kt;
#pragma unroll
                for (int r = 0; r < 16; ++r) { const int j = 32 * jt + (r & 3) + 8 * (r >> 2) + 4 * hh, rel = j - 128 - qi, kpos = nb * 128 - 128 + j;
                    const bool ok = rel >= -128 && rel <= 128 && kpos >= 0 && kpos < SEQ;
                    const int ridx = ok ? rel + 128 : 0;
                    const float s = ok ? Sa[kt][r] + btab[hq * 260 + ridx] : -INFINITY;
                    Sa[kt][r] = s; gmax = fmaxf(gmax, s); } }
            gmax = fmaxf(gmax, __shfl_xor(gmax, 32));
            const float mnew = fmaxf(mrun, gmax), alpha = __expf(mrun - mnew); mrun = mnew;
            float psum = 0.f;
#pragma unroll
            for (int kt = 0; kt < 3; ++kt)
#pragma unroll
                for (int r = 0; r < 16; ++r) { const float p = __expf(Sa[kt][r] - mnew); Sa[kt][r] = p; psum += p; }
            lsum = lsum * alpha + psum;
#pragma unroll
            for (int r = 0; r < 16; ++r) { O0[r] *= alpha; O1[r] *= alpha; }
#pragma unroll
            for (int kt = 0; kt < 3; ++kt) { const int jt = rb + 3 * tg + kt;
#pragma unroll
                for (int s2 = 0; s2 < 2; ++s2) {
                    u32x4 pw; pw.x = pk2(Sa[kt][8 * s2 + 0], Sa[kt][8 * s2 + 1]); pw.y = pk2(Sa[kt][8 * s2 + 2], Sa[kt][8 * s2 + 3]);
                    pw.z = pk2(Sa[kt][8 * s2 + 4], Sa[kt][8 * s2 + 5]); pw.w = pk2(Sa[kt][8 * s2 + 6], Sa[kt][8 * s2 + 7]);
                    const bf16x8 pf = __builtin_bit_cast(bf16x8, pw);
                    const int kb = 32 * jt + 16 * s2 + 4 * hh;
                    { const u32x2 lo = *(const LAS u32x2*)(VT + l31 * 392 + kb), hi = *(const LAS u32x2*)(VT + l31 * 392 + kb + 8);
                      const u32x4 vw = (u32x4){lo.x, lo.y, hi.x, hi.y}; O0 = __builtin_amdgcn_mfma_f32_32x32x16_bf16(__builtin_bit_cast(bf16x8, vw), pf, O0, 0, 0, 0); }
                    { const u32x2 lo = *(const LAS u32x2*)(VT + (32 + l31) * 392 + kb), hi = *(const LAS u32x2*)(VT + (32 + l31) * 392 + kb + 8);
                      const u32x4 vw = (u32x4){lo.x, lo.y, hi.x, hi.y}; O1 = __builtin_amdgcn_mfma_f32_32x32x16_bf16(__builtin_bit_cast(bf16x8, vw), pf, O1, 0, 0, 0); }
                } }
        }
        lsum += __shfl_xor(lsum, 32);
        const float inv = 1.0f / lsum;
        bf16* yrow = Y + (size_t)tok * D + 512 + head * 64;
#pragma unroll
        for (int q4 = 0; q4 < 4; ++q4) {
            u32x2 w0, w1;
            w0.x = pk2(O0[4 * q4] * inv, O0[4 * q4 + 1] * inv); w0.y = pk2(O0[4 * q4 + 2] * inv, O0[4 * q4 + 3] * inv);
            w1.x = pk2(O1[4 * q4] * inv, O1[4 * q4 + 1] * inv); w1.y = pk2(O1[4 * q4 + 2] * inv, O1[4 * q4 + 3] * inv);
            *(u32x2*)(yrow + 8 * q4 + 4 * hh) = w0; *(u32x2*)(yrow + 32 + 8 * q4 + 4 * hh) = w1;
        }
    }
}

__device__ __forceinline__ void dt_phase(const Frame& F, const Args& A) {
    const int lane = F.lane, wave = F.wave, tid = F.tid, fr = lane & 15, fq = lane >> 4;
    const bf16* XN = (const bf16*)(F.ws + WS_XN);
    const bf16* Wdt = (const bf16*)(F.ws + WS_WSIN) + (size_t)5120 * 1024;
    float* DT = (float*)(F.ws + WS_DT);
    LAS float* part = (LAS float*)F.lds;
    for (int blk = blockIdx.x; blk < T / 64; blk += F.G) {
        const int row0 = blk * 64;
        f32x4 acc[4][4];
#pragma unroll
        for (int m = 0; m < 4; ++m)
#pragma unroll
            for (int n = 0; n < 4; ++n) acc[m][n] = (f32x4){0.f, 0.f, 0.f, 0.f};
#pragma unroll
        for (int ks = 0; ks < 4; ++ks) {
            const int k0 = wave * 128 + ks * 32 + fq * 8;
            bf16x8 af[4], bfm[4];
#pragma unroll
            for (int m = 0; m < 4; ++m) af[m] = *(const bf16x8*)(XN + (size_t)(row0 + m * 16 + fr) * D + k0);
#pragma unroll
            for (int n = 0; n < 4; ++n) bfm[n] = *(const bf16x8*)(Wdt + (size_t)(n * 16 + fr) * D + k0);
#pragma unroll
            for (int m = 0; m < 4; ++m)
#pragma unroll
                for (int n = 0; n < 4; ++n) acc[m][n] = __builtin_amdgcn_mfma_f32_16x16x32_bf16(af[m], bfm[n], acc[m][n], 0, 0, 0);
        }
        __syncthreads();
#pragma unroll
        for (int m = 0; m < 4; ++m)
#pragma unroll
            for (int n = 0; n < 4; ++n)
#pragma unroll
                for (int i = 0; i < 4; ++i) part[wave * 4096 + (m * 16 + 4 * fq + i) * 64 + n * 16 + fr] = acc[m][n][i];
        __syncthreads();
        for (int i = tid; i < 4096; i += 512) {
            float v = 0.f;
#pragma unroll
            for (int w = 0; w < 8; ++w) v += part[w * 4096 + i];
            const int col = i & 63;
            v += (col < 32) ? A.in[I_ODTBF][col] : A.in[I_ODTBB][col - 32];
            const float sp = v > 20.f ? v : log1pf(__expf(v));
            DT[(size_t)(row0 + (i >> 6)) * 64 + col] = sp;
        }
    }
}

constexpr int SS_XT = 0, SS_BN = 17408, SS_BT = 52224, SS_CN = 87040, SS_ST = 121856, SS_SC = 139264;
constexpr int RS = 136;
__device__ __forceinline__ void ssd_stage(const Frame& F, const Args& A, int b, int h, int c) {
    const int tid = F.tid;
    const int g = h >> 3;
    LAS bf16* XT = (LAS bf16*)(F.lds + SS_XT); LAS bf16* Bn = (LAS bf16*)(F.lds + SS_BN); LAS bf16* BT = (LAS bf16*)(F.lds + SS_BT); LAS bf16* Cn = (LAS bf16*)(F.lds + SS_CN);
    const bf16* XBC = (const bf16*)(F.ws + WS_XBC);
    for (int it = tid; it < 640; it += 512) {
        const int ch8 = it % 40, tg = it / 40, l0 = tg * 8;
        const int kind = ch8 < 8 ? 0 : (ch8 < 24 ? 1 : 2);
        const int cc = kind == 0 ? ch8 * 8 : (kind == 1 ? (ch8 - 8) * 8 : (ch8 - 24) * 8);
        const int col = kind == 0 ? h * 64 + cc : (kind == 1 ? 2048 + g * 128 + cc : 2560 + g * 128 + cc);
        u32x4 inr[12];
#pragma unroll
        for (int r = 0; r < 12; ++r) { const int pos = c * 128 + l0 + r - 2;
            inr[r] = (u32x4){0u, 0u, 0u, 0u};
            if (pos >= 0 && pos < SEQ) inr[r] = *(const u32x4*)(XBC + (size_t)(b * SEQ + pos) * CDIM + col); }
        float o[8][8];
#pragma unroll
        for (int e = 0; e < 8; ++e) {
            float wv[5];
#pragma unroll
            for (int i = 0; i < 5; ++i) wv[i] = A.in[I_OCONVW][i * CDIM + col + e];
            const float bv = A.in[I_OCONVB][col + e];
            float xin[12];
#pragma unroll
            for (int r = 0; r < 12; ++r) { const unsigned w = (e >> 1) == 0 ? inr[r].x : ((e >> 1) == 1 ? inr[r].y : ((e >> 1) == 2 ? inr[r].z : inr[r].w)); xin[r] = (e & 1) ? bfhi(w) : bflo(w); }
#pragma unroll
            for (int t = 0; t < 8; ++t) { float sacc = bv;
#pragma unroll
                for (int i = 0; i < 5; ++i) sacc += xin[t + i] * wv[i];
                o[t][e] = sacc / (1.0f + __expf(-sacc)); }
        }
        if (kind != 0) {
            LAS bf16* Nn = kind == 1 ? Bn : Cn;
#pragma unroll
            for (int t = 0; t < 8; ++t) { u32x4 w; w.x = pk2(o[t][0], o[t][1]); w.y = pk2(o[t][2], o[t][3]); w.z = pk2(o[t][4], o[t][5]); w.w = pk2(o[t][6], o[t][7]);
                *(LAS u32x4*)(Nn + (l0 + t) * RS + cc) = w; }
        }
        if (kind != 2) {
            LAS bf16* Tt = kind == 0 ? XT : BT;
#pragma unroll
            for (int e = 0; e < 8; ++e) { u32x4 w; w.x = pk2(o[0][e], o[1][e]); w.y = pk2(o[2][e], o[3][e]); w.z = pk2(o[4][e], o[5][e]); w.w = pk2(o[6][e], o[7][e]);
                *(LAS u32x4*)(Tt + (cc + e) * RS + l0) = w; }
        }
    }
}
__device__ __forceinline__ void ssd_scalars(const Frame& F, const Args& A, int b, int h, int c) {
    const int lane = F.lane, wave = F.wave;
    LAS float* sc = (LAS float*)(F.lds + SS_SC);
    LAS float* dtf = sc, *dtb = sc + 128, *af = sc + 256, *rbv = sc + 384, *eaf = sc + 512, *wf = sc + 640, *erb = sc + 768, *wb = sc + 896;
    const float* DT = (const float*)(F.ws + WS_DT);
    if (wave == 0) {
        const float Af = -__expf(A.in[I_OALF][h]);
        const float d0 = DT[(size_t)(b * SEQ + c * 128 + 2 * lane) * 64 + h], d1 = DT[(size_t)(b * SEQ + c * 128 + 2 * lane + 1) * 64 + h];
        const float a0 = Af * d0, a1 = Af * d1; float s = a0 + a1;
#pragma unroll
        for (int o = 1; o < 64; o <<= 1) { const float t = __shfl_up(s, o); if (lane >= o) s += t; }
        const float tot = __shfl(s, 63), c1 = s, c0 = s - a1;
        dtf[2 * lane] = d0; dtf[2 * lane + 1] = d1; af[2 * lane] = c0; af[2 * lane + 1] = c1;
        eaf[2 * lane] = __expf(c0); eaf[2 * lane + 1] = __expf(c1);
        wf[2 * lane] = __expf(tot - c0) * d0; wf[2 * lane + 1] = __expf(tot - c1) * d1;
    } else if (wave == 1) {
        const float Ab = -__expf(A.in[I_OALB][h]);
        const float d0 = DT[(size_t)(b * SEQ + c * 128 + 2 * lane) * 64 + 32 + h], d1 = DT[(size_t)(b * SEQ + c * 128 + 2 * lane + 1) * 64 + 32 + h];
        const float a0 = Ab * d0, a1 = Ab * d1; float s = a0 + a1;
#pragma unroll
        for (int o = 1; o < 64; o <<= 1) { const float t = __shfl_up(s, o); if (lane >= o) s += t; }
        const float tot = __shfl(s, 63);
        const float r0 = tot - s + a0 + a1, r1 = tot - s + a1;
        dtb[2 * lane] = d0; dtb[2 * lane + 1] = d1; rbv[2 * lane] = r0; rbv[2 * lane + 1] = r1;
        erb[2 * lane] = __expf(r0); erb[2 * lane + 1] = __expf(r1);
        wb[2 * lane] = __expf(tot - r0) * d0; wb[2 * lane + 1] = __expf(tot - r1) * d1;
    }
}
__device__ __forceinline__ bf16x8 pack8(const f32x16& v, int s2) {
    u32x4 w; w.x = pk2(v[8 * s2 + 0], v[8 * s2 + 1]); w.y = pk2(v[8 * s2 + 2], v[8 * s2 + 3]); w.z = pk2(v[8 * s2 + 4], v[8 * s2 + 5]); w.w = pk2(v[8 * s2 + 6], v[8 * s2 + 7]);
    return __builtin_bit_cast(bf16x8, w);
}
__device__ __forceinline__ void ssd_unit(const Frame& F, const Args& A, int b, int h) {
    const int tid = F.tid, lane = F.lane, wave = F.wave, l31 = lane & 31, hh = lane >> 5;
    LAS bf16* XT = (LAS bf16*)(F.lds + SS_XT); LAS bf16* Bn = (LAS bf16*)(F.lds + SS_BN); LAS bf16* BT = (LAS bf16*)(F.lds + SS_BT); LAS bf16* Cn = (LAS bf16*)(F.lds + SS_CN);
    LAS bf16* St = (LAS bf16*)(F.lds + SS_ST);
    LAS float* sc = (LAS float*)(F.lds + SS_SC);
    LAS float* dtf = sc, *dtb = sc + 128, *af = sc + 256, *rbv = sc + 384, *eaf = sc + 512, *wf = sc + 640, *erb = sc + 768, *wb = sc + 896;
    bf16* YM = (bf16*)(F.ws + WS_YM);
    const float Dh = A.in[I_OD][h];
    const int lt = wave & 3, pt = wave >> 2;
    const int pt2 = wave & 1, nt = wave >> 1;
    for (int sweep = 0; sweep < 2; ++sweep) {
        __syncthreads();
        for (int i = tid; i < 64 * RS / 2; i += 512) ((LAS unsigned*)St)[i] = 0u;
        f32x16 stacc;
#pragma unroll
        for (int r = 0; r < 16; ++r) stacc[r] = 0.f;
        for (int ci = 0; ci < 16; ++ci) {
            const int c = sweep ? 15 - ci : ci;
            __syncthreads();
            ssd_stage(F, A, b, h, c);
            ssd_scalars(F, A, b, h, c);
            __syncthreads();
            const int l = 32 * lt + l31, p = 32 * pt + l31;
            f32x16 Yd;
#pragma unroll
            for (int r = 0; r < 16; ++r) Yd[r] = 0.f;
            if (sweep == 0) {
                const float myaf = af[l], myrb = rbv[l];
#pragma unroll 1
                for (int st = 0; st < 4; ++st) {
                    f32x16 cb;
#pragma unroll
                    for (int r = 0; r < 16; ++r) cb[r] = 0.f;
#pragma unroll
                    for (int ks = 0; ks < 8; ++ks) { const bf16x8 cf = *(const LAS bf16x8*)(Cn + l * RS + 16 * ks + 8 * hh);
                        const bf16x8 bfr = *(const LAS bf16x8*)(Bn + (32 * st + l31) * RS + 16 * ks + 8 * hh);
                        cb = __builtin_amdgcn_mfma_f32_32x32x16_bf16(bfr, cf, cb, 0, 0, 0); }
#pragma unroll
                    for (int r4 = 0; r4 < 4; ++r4) { const int s0 = 32 * st + 8 * r4 + 4 * hh;
                        const f32x4 afs = *(const LAS f32x4*)(af + s0), rbs = *(const LAS f32x4*)(rbv + s0), dfs = *(const LAS f32x4*)(dtf + s0), dbs = *(const LAS f32x4*)(dtb + s0);
#pragma unroll
                        for (int j = 0; j < 4; ++j) { const int s = s0 + j;
                            const float wgt = (s < l) ? __expf(myaf - afs[j]) * dfs[j] : ((s > l) ? __expf(myrb - rbs[j]) * dbs[j] : (dfs[j] + dbs[j]));
                            cb[4 * r4 + j] *= wgt; } }
#pragma unroll
                    for (int s2 = 0; s2 < 2; ++s2) { const int kb = 32 * st + 16 * s2 + 4 * hh;
                        const u32x2 lo = *(const LAS u32x2*)(XT + p * RS + kb), hi = *(const LAS u32x2*)(XT + p * RS + kb + 8);
                        const u32x4 xw = (u32x4){lo.x, lo.y, hi.x, hi.y};
                        Yd = __builtin_amdgcn_mfma_f32_32x32x16_bf16(pack8(cb, s2), __builtin_bit_cast(bf16x8, xw), Yd, 0, 0, 0); }
                }
            }
            f32x16 Yo;
#pragma unroll
            for (int r = 0; r < 16; ++r) Yo[r] = 0.f;
#pragma unroll
            for (int ks = 0; ks < 8; ++ks) { const bf16x8 cf = *(const LAS bf16x8*)(Cn + l * RS + 16 * ks + 8 * hh); const bf16x8 sf = *(const LAS bf16x8*)(St + p * RS + 16 * ks + 8 * hh);
                Yo = __builtin_amdgcn_mfma_f32_32x32x16_bf16(cf, sf, Yo, 0, 0, 0); }
            LAS float* esc = sweep ? erb : eaf;
#pragma unroll
            for (int r = 0; r < 16; ++r) { const int lrow = 32 * lt + (r & 3) + 8 * (r >> 2) + 4 * hh;
                bf16* yp = YM + (size_t)(b * SEQ + c * 128 + lrow) * DI + h * 64 + p;
                float y = esc[lrow] * Yo[r];
                if (sweep == 0) y += Yd[r] + Dh * bf1(XT[p * RS + lrow]); else y += bf1(*yp);
                *yp = (bf16)(pk2(y, 0.f) & 0xffffu); }
            __syncthreads();
            {
                const float decay = sweep ? erb[0] : eaf[127];
                LAS float* wsel = sweep ? wb : wf;
#pragma unroll
                for (int r = 0; r < 16; ++r) stacc[r] *= decay;
                const int pp = 32 * pt2 + l31, nn = 32 * nt + l31;
#pragma unroll
                for (int ks = 0; ks < 8; ++ks) { const int l0 = 16 * ks + 8 * hh;
                    const u32x4 xr = *(const LAS u32x4*)(XT + pp * RS + l0); const f32x4 w0 = *(const LAS f32x4*)(wsel + l0), w1 = *(const LAS f32x4*)(wsel + l0 + 4);
                    u32x4 xs; xs.x = pk2(bflo(xr.x) * w0[0], bfhi(xr.x) * w0[1]); xs.y = pk2(bflo(xr.y) * w0[2], bfhi(xr.y) * w0[3]);
                    xs.z = pk2(bflo(xr.z) * w1[0], bfhi(xr.z) * w1[1]); xs.w = pk2(bflo(xr.w) * w1[2], bfhi(xr.w) * w1[3]);
                    const bf16x8 bt = *(const LAS bf16x8*)(BT + nn * RS + l0);
                    stacc = __builtin_amdgcn_mfma_f32_32x32x16_bf16(__builtin_bit_cast(bf16x8, xs), bt, stacc, 0, 0, 0); }
#pragma unroll
                for (int r = 0; r < 16; ++r) { const int prow = 32 * pt2 + (r & 3) + 8 * (r >> 2) + 4 * hh; St[prow * RS + nn] = (bf16)(pk2(stacc[r], 0.f) & 0xffffu); }
            }
        }
    }
}

__device__ __forceinline__ void gnorm_phase(const Frame& F, const Args& A) {
    const int lane = F.lane;
    const bf16* YM = (const bf16*)(F.ws + WS_YM); const bf16* Z = (const bf16*)(F.ws + WS_Z); bf16* YN = (bf16*)(F.ws + WS_YN);
    const float* gw = A.in[I_OGN];
    const int gwv = F.vcu * 8 + F.wave, NGW = F.G * 8;
    for (int row = gwv; row < T; row += NGW) {
        float v[32]; float ss = 0.f;
#pragma unroll
        for (int j = 0; j < 4; ++j) { const int c = 8 * lane + 512 * j;
            const u32x4 y4 = *(const u32x4*)(YM + (size_t)row * DI + c), z4 = *(const u32x4*)(Z + (size_t)row * DI + c);
            const unsigned yw[4] = {y4.x, y4.y, y4.z, y4.w}, zw[4] = {z4.x, z4.y, z4.z, z4.w};
#pragma unroll
            for (int e = 0; e < 4; ++e) { const float a = bflo(yw[e]) * siluf(bflo(zw[e])), c2 = bfhi(yw[e]) * siluf(bfhi(zw[e])); v[j * 8 + 2 * e] = a; v[j * 8 + 2 * e + 1] = c2; ss += a * a + c2 * c2; } }
        const float rstd = 1.0f / sqrtf(wave_sum(ss) * (1.0f / DI) + EPS);
#pragma unroll
        for (int j = 0; j < 4; ++j) { const int c = 8 * lane + 512 * j; const f32x4 g0 = *(const f32x4*)(gw + c), g1 = *(const f32x4*)(gw + c + 4);
            u32x4 o; o.x = pk2(v[j * 8] * rstd * g0[0], v[j * 8 + 1] * rstd * g0[1]); o.y = pk2(v[j * 8 + 2] * rstd * g0[2], v[j * 8 + 3] * rstd * g0[3]);
            o.z = pk2(v[j * 8 + 4] * rstd * g1[0], v[j * 8 + 5] * rstd * g1[1]); o.w = pk2(v[j * 8 + 6] * rstd * g1[2], v[j * 8 + 7] * rstd * g1[3]);
            *(u32x4*)(YN + (size_t)row * DI + c) = o; }
    }
}

__device__ __forceinline__ int moe_tables(const Frame& F, LAS int* pexp  , LAS int* eoff  , LAS int* ecnt  ) {
    const unsigned* gcnt = (const unsigned*)(F.ws + WS_CTL) + CW_GCNT;
    __syncthreads();
    if (F.tid == 0) { int off = 0; for (int e = 0; e < 8; ++e) { const int cnt = (int)__hip_atomic_load(gcnt + e, __ATOMIC_RELAXED, __HIP_MEMORY_SCOPE_AGENT); ecnt[e] = cnt; eoff[e] = off; const int np = (cnt + 255) >> 8;
            for (int p = 0; p < np; ++p) pexp[(off >> 8) + p] = e; off += np << 8; } eoff[8] = off; }
    __syncthreads();
    return eoff[8] >> 8;
}
__device__ __forceinline__ void gather_phase(const Frame& F) {
    LAS int* pexp = (LAS int*)F.lds; LAS int* eoff = pexp + MAXPAN; LAS int* ecnt = eoff + 9;
    const int npan = moe_tables(F, pexp, eoff, ecnt);
    const int* toke = (const int*)(F.ws + WS_ROUTE + RT_TOKE); const int* tokp = (const int*)(F.ws + WS_ROUTE + RT_TOKP); const float* tokw = (const float*)(F.ws + WS_ROUTE + RT_TOKW);
    int* rowtok = (int*)(F.ws + WS_ROUTE + RT_ROWTOK); float* roww = (float*)(F.ws + WS_ROUTE + RT_ROWW);
    const bf16* XN = (const bf16*)(F.ws + WS_XN); bf16* AP = (bf16*)(F.ws + WS_AP);
    const int gwv = F.vcu * 8 + F.wave, NGW = F.G * 8, lane = F.lane;
    for (int i = gwv; i < T * 2; i += NGW) {
        const int e = toke[i], row = eoff[e] + tokp[i], tok = i >> 1;
        if (lane == 0) { rowtok[row] = tok; roww[row] = tokw[i]; }
        const u32x4* src = (const u32x4*)(XN + (size_t)tok * D); u32x4* dst = (u32x4*)(AP + (size_t)row * D);
        dst[lane] = src[lane]; dst[lane + 64] = src[lane + 64];
    }
    const int npad_total = npan * 256;
    for (int row = gwv; row < npad_total; row += NGW) {
        const int e = pexp[row >> 8];
        if (row >= eoff[e] + ecnt[e]) { if (lane == 0) { rowtok[row] = -1; roww[row] = 0.f; }
            u32x4* dst = (u32x4*)(AP + (size_t)row * D); dst[lane] = (u32x4){0u, 0u, 0u, 0u}; dst[lane + 64] = (u32x4){0u, 0u, 0u, 0u}; }
    }
}

constexpr int NPHASE = 17;
__global__ void __launch_bounds__(512, 2) hybrid_fwd(Args args) {
    extern __shared__ __attribute__((aligned(16))) unsigned char lds_raw[];
    Frame F;
    F.lds = (LAS unsigned char*)lds_raw; F.ws = args.ws;
    F.tid = threadIdx.x; F.lane = F.tid & 63; F.wave = __builtin_amdgcn_readfirstlane(F.tid >> 6);
    F.G = gridDim.x; { const int bx = blockIdx.x; F.vcu = (F.G % 8 == 0) ? (bx % 8) * (F.G / 8) + bx / 8 : bx; }
    volatile LAS unsigned* MISC = (volatile LAS unsigned*)(F.lds + MISC_OFF);
    if (F.tid < 32) MISC[F.tid] = 0u;
    __syncthreads();
    unsigned* ctl = (unsigned*)(args.ws + WS_CTL);
    XcdBarrier bar; bar.bar = ctl + CW_BAR; bar.x = 0; bar.st = nullptr;
#if MK_N_LAUNCHES == 1
    bar = xcd_barrier_post(ctl + CW_BAR, MISC + 8);
#define GRID_BAR() xcd_barrier(bar)
#else
#define GRID_BAR() do { } while (0)
#endif
    const int lo = args.ph_lo, hi = args.ph_hi;
#ifndef PHASE_MASK
#define PHASE_MASK 0x1ffff
#endif
#define IN(k) ((((PHASE_MASK) >> (k)) & 1) && lo <= (k) && (k) < hi)
#define SEAM(k) do { if (IN(k) && IN((k) + 1)) GRID_BAR(); } while (0)
    unsigned char* ws = args.ws;
    const float* MOD = (const float*)(ws + WS_MOD);
    const int c = (int)blockIdx.x;

    if (IN(0)) { p0_prologue(F, args); } SEAM(0);
    if (IN(1)) { modulate_phase<0>(F, args, args.in[I_X], args.in[I_EN1], 0, 0); } SEAM(1);
    if (IN(2)) {
        { SchedPlain S{(const char*)(ws + WS_WU), (const char*)(ws + WS_XN), 4, 64, F.G, c, (size_t)256 * 1024 * 2}; EpiUT E{(bf16*)(ws + WS_UT)};
          pg8::gemm_phase(F.lds, 1024, S, E); }
        { SchedPlain S{(const char*)(ws + WS_XN), (const char*)(ws + WS_WQKV), 64, 3, F.G, c, (size_t)256 * 1024 * 2}; EpiBf16 E{(bf16*)(ws + WS_QKV), QKVW};
          pg8::gemm_phase(F.lds, 1024, S, E); }
    } SEAM(2);
    if (IN(3)) {
        const int sub = F.vcu & 31, x = F.vcu >> 5;
        if (sub < 16) { SchedFourier S{(const char*)(ws + WS_FDFT), (const char*)(ws + WS_UT), x * 16 + sub}; EpiBf16 E{(bf16*)(ws + WS_Y0), D};
            pg8::gemm_phase(F.lds, 4096, S, E); }
        else { const int a = sub - 16; attn_unit(F, args, x, a, 0); attn_unit(F, args, x, a, 1); }
    } SEAM(3);
    if (IN(4)) { SchedPlain S{(const char*)(ws + WS_Y0), (const char*)(ws + WS_WO0), 64, 4, F.G, c, (size_t)256 * 1024 * 2}; EpiRes E{args.in[I_X], args.out, MOD + 2048};
        pg8::gemm_phase(F.lds, 1024, S, E); } SEAM(4);
    if (IN(5)) { modulate_phase<1>(F, args, args.out, args.in[I_EN2], 0, 1); } SEAM(5);
    if (IN(6)) { SchedPlain S{(const char*)(ws + WS_XN), (const char*)(ws + WS_WF13), 64, 22, F.G, c, (size_t)256 * 1024 * 2}; EpiSwiglu E{(bf16*)(ws + WS_H0), DFF};
        pg8::gemm_phase(F.lds, 1024, S, E); } SEAM(6);
    if (IN(7)) { SchedPlain S{(const char*)(ws + WS_H0), (const char*)(ws + WS_WF2), 64, 4, F.G, c, (size_t)256 * DFF * 2}; EpiRes E{args.out, args.out, MOD + 5120};
        pg8::gemm_phase(F.lds, DFF, S, E); } SEAM(7);
    if (IN(8)) { modulate_phase<1>(F, args, args.out, args.in[I_ON1], 1, 0); } SEAM(8);
    if (IN(9)) { { SchedPlain S{(const char*)(ws + WS_XN), (const char*)(ws + WS_WSIN), 64, 20, F.G, c, (size_t)256 * 1024 * 2}; EpiSsmIn E{(bf16*)(ws + WS_Z), (bf16*)(ws + WS_XBC)};
        pg8::gemm_phase(F.lds, 1024, S, E); } dt_phase(F, args); } SEAM(9);
    if (IN(10)) { for (int u = F.vcu; u < NBATCH * NHEAD_SSM; u += F.G) ssd_unit(F, args, u >> 5, u & 31); } SEAM(10);
    if (IN(11)) { gnorm_phase(F, args); } SEAM(11);
    if (IN(12)) { SchedPlain S{(const char*)(ws + WS_YN), (const char*)(ws + WS_WSOUT), 64, 4, F.G, c, (size_t)256 * DI * 2}; EpiRes E{args.out, args.out, MOD + 49152 + 2048};
        pg8::gemm_phase(F.lds, DI, S, E); } SEAM(12);
    if (IN(13)) { modulate_phase<2>(F, args, args.out, args.in[I_ON2], 1, 1); } SEAM(13);
    if (IN(14)) { gather_phase(F); } SEAM(14);
    if (IN(15)) { LAS int* pexp = (LAS int*)(F.lds + 131072 + 4096); LAS int* eoff = pexp + MAXPAN; LAS int* ecnt = eoff + 9;
        const int npan = moe_tables(F, pexp, eoff, ecnt);
        SchedMoe S{(const char*)(ws + WS_AP), (const char*)(ws + WS_WM13), pexp, npan, 28, F.G, c, (size_t)256 * 1024 * 2, (size_t)256 * 1024 * 2, 28}; EpiSwiglu E{(bf16*)(ws + WS_HP), DFE};
        pg8::gemm_phase(F.lds, 1024, S, E); } SEAM(15);
    if (IN(16)) { LAS int* pexp = (LAS int*)(F.lds + 131072 + 4096); LAS int* eoff = pexp + MAXPAN; LAS int* ecnt = eoff + 9;
        const int npan = moe_tables(F, pexp, eoff, ecnt);
        SchedMoe S{(const char*)(ws + WS_HP), (const char*)(ws + WS_WM2), pexp, npan, 4, F.G, c, (size_t)256 * DFE * 2, (size_t)256 * DFE * 2, 4};
        EpiMoeDown E{args.out, MOD + 49152 + 5120, (const int*)(ws + WS_ROUTE + RT_ROWTOK), (const float*)(ws + WS_ROUTE + RT_ROWW)};
        pg8::gemm_phase(F.lds, DFE, S, E); }
#undef IN
#undef SEAM
}

extern "C" void kernel_launch(void* const* d_in, const int* in_sizes, int n_in, void* d_out, int out_size, void* d_ws, size_t ws_size, hipStream_t stream) {
    static int grid = 0;
    if (grid == 0) {
        if (n_in != 34 || ws_size < WS_END) { grid = -1; return; }
        int dev = 0, cus = 0;
        if (hipGetDevice(&dev) != hipSuccess || hipDeviceGetAttribute(&cus, hipDeviceAttributeMultiprocessorCount, dev) != hipSuccess) { grid = -1; return; }
        if (hipFuncSetAttribute((const void*)hybrid_fwd, hipFuncAttributeMaxDynamicSharedMemorySize, LDS_BYTES) != hipSuccess) { grid = -1; return; }
        int per_cu = 0;
        (void)hipOccupancyMaxActiveBlocksPerMultiprocessor(&per_cu, (const void*)hybrid_fwd, 512, LDS_BYTES);
        (void)hipGetLastError();
        grid = cus;
    }
    if (grid < 0) return;
    (void)hipMemsetAsync((char*)d_ws + WS_CTL, 0, CTL_ZERO_BYTES, stream);
    Args a{};
    for (int i = 0; i < 34; ++i) a.in[i] = (const float*)d_in[i];
    a.out = (float*)d_out; a.ws = (unsigned char*)d_ws;
#if MK_N_LAUNCHES == 1
    a.ph_lo = 0; a.ph_hi = NPHASE;
    hipLaunchKernelGGL(hybrid_fwd, dim3(grid), dim3(512), LDS_BYTES, stream, a);
#else
    for (int p = 0; p < NPHASE; ++p) { a.ph_lo = p; a.ph_hi = p + 1; hipLaunchKernelGGL(hybrid_fwd, dim3(grid), dim3(512), LDS_BYTES, stream, a); }
#endif
}
```

```cpp
#include <hip/hip_runtime.h>
#include <stdint.h>

#ifndef MK_N_LAUNCHES
#define MK_N_LAUNCHES 1
#endif

#define LAS __attribute__((address_space(3)))
#define GAS __attribute__((address_space(1)))
typedef unsigned short bf16;
typedef short bf16x8 __attribute__((ext_vector_type(8)));
typedef float f32x4 __attribute__((ext_vector_type(4)));
typedef float f32x16 __attribute__((ext_vector_type(16)));
typedef unsigned u32x4 __attribute__((ext_vector_type(4)));
typedef unsigned u32x2 __attribute__((ext_vector_type(2)));

constexpr int D = 1024, NBATCH = 8, SEQ = 2048, T = NBATCH * SEQ;
constexpr int DFF = 2816, DI = 2048, CDIM = 3072, NHEAD_SSM = 32, NEXP = 8, DFE = 3584;
constexpr int QKVW = 768;
constexpr int MAXPAN = 136;
constexpr float EPS = 1e-6f;

constexpr size_t MiB = 1u << 20;
constexpr size_t WS_CTL = 0, CTL_ZERO_BYTES = 1 * MiB;
constexpr size_t WS_MODP = 1 * MiB;
constexpr size_t WS_MOD = 7 * MiB;
constexpr size_t WS_ROUTE = 7 * MiB + 512 * 1024;
constexpr size_t WS_WM13 = 9 * MiB;
constexpr size_t WS_WM2 = 121 * MiB;
constexpr size_t WS_WU = 192 * MiB;
constexpr size_t WS_WQKV = 194 * MiB;
constexpr size_t WS_WO0 = 196 * MiB;
constexpr size_t WS_WF13 = 198 * MiB;
constexpr size_t WS_WF2 = 209 * MiB;
constexpr size_t WS_WSIN = 181 * MiB;
constexpr size_t WS_WSOUT = 177 * MiB;
constexpr size_t WS_FDFT = 215 * MiB;
constexpr size_t WS_ACT = 231 * MiB;
constexpr size_t WS_XN = WS_ACT;
constexpr size_t WS_UT = WS_ACT + 32 * MiB;
constexpr size_t WS_QKV = WS_ACT + 64 * MiB;
constexpr size_t WS_Y0 = WS_ACT + 88 * MiB;
constexpr size_t WS_H0 = WS_ACT + 120 * MiB;
constexpr size_t WS_Z = WS_ACT + 32 * MiB;
constexpr size_t WS_XBC = WS_ACT + 96 * MiB;
constexpr size_t WS_DT = WS_ACT + 192 * MiB;
constexpr size_t WS_YM = WS_ACT + 196 * MiB;
constexpr size_t WS_YN = WS_XBC;
constexpr size_t WS_HP = 177 * MiB;
constexpr size_t WS_AP = 415 * MiB;
constexpr size_t WS_XT = 181 * MiB;
constexpr size_t WS_BT = 245 * MiB;
constexpr size_t WS_CN = WS_ACT + 260 * MiB;
constexpr size_t WS_SC = 1 * MiB;
constexpr size_t WS_YS = WS_WM13;
constexpr size_t WS_END = 507 * MiB;
constexpr size_t RT_TOKE = 0;
constexpr size_t RT_TOKP = 131072;
constexpr size_t RT_TOKW = 262144;
constexpr size_t RT_ROWTOK = 393216;
constexpr size_t RT_ROWW = 393216 + 139264;
constexpr int CW_BAR = 4096;
constexpr int CW_GCNT = 16384;

constexpr int LDS_BYTES = 163840 - 512;
constexpr int MISC_OFF = 160000;

__device__ __forceinline__ unsigned pk2(float lo, float hi) { unsigned r; asm volatile("v_cvt_pk_bf16_f32 %0, %1, %2" : "=v"(r) : "v"(lo), "v"(hi)); return r; }
__device__ __forceinline__ float bflo(unsigned u) { return __uint_as_float(u << 16); }
__device__ __forceinline__ float bfhi(unsigned u) { return __uint_as_float(u & 0xffff0000u); }
__device__ __forceinline__ float bf1(bf16 b) { return __uint_as_float(((unsigned)b) << 16); }
__device__ __forceinline__ float siluf(float x) { return x / (1.0f + __expf(-x)); }
__device__ __forceinline__ float wave_sum(float v) {
#pragma unroll
    for (int o = 1; o < 64; o <<= 1) v += __shfl_xor(v, o);
    return v;
}
#define LDS_WAIT() asm volatile("s_waitcnt lgkmcnt(0)" ::: "memory")
#define VM_WAIT() asm volatile("s_waitcnt vmcnt(0)" ::: "memory")

namespace pg8 {
constexpr int BM = 256, BK = 64, HALF = 128, HTB = HALF * BK * 2, STAGE_BYTES = 8 * HTB, NXCD = 8, WGM = 8;
__host__ __device__ __forceinline__ int lds_byte(int r, int c) { const int st = (r >> 4) * 2 + (c >> 5), rr = r & 15, cc = c & 31, ob = rr * 64 + cc * 2; return st * 1024 + (ob ^ (((ob >> 9) & 1) << 5)); }
__host__ __device__ __forceinline__ void stage_rc(int b, int& R, int& C) { const int st = b / 1024, sb = b % 1024, swz = sb ^ (((sb >> 9) & 1) << 5); R = (st >> 1) * 16 + swz / 64; C = (st & 1) * 32 + (swz % 64) / 2; }
__host__ __device__ __forceinline__ int perm32(int rho) { const int n = rho >> 4, i = rho & 15; return 8 * (i >> 2) + 4 * n + (i & 3); }

struct Unit { const char* a; const char* b; int pm, pn; };

__device__ __forceinline__ bool tile_order(int i, int G, int c, int nM, int nN, int& pm, int& pn) {
    const int nwg = nM * nN; const long L = (long)i * G + c; if (L >= nwg) return false;
    int wgid = (int)L; { const int q = nwg / NXCD, r = nwg % NXCD, xcd = wgid % NXCD, off = wgid / NXCD; wgid = (xcd < r ? xcd * (q + 1) : r * (q + 1) + (xcd - r) * q) + off; }
    const int nig = WGM * nN, gid = wgid / nig, fm = gid * WGM, gsz = (nM - fm) < WGM ? (nM - fm) : WGM;
    pm = fm + ((wgid % nig) % gsz); pn = (wgid % nig) / gsz; return true;
}

template <class Epi, class Sched>
__device__ __forceinline__ void gemm_phase(LAS unsigned char* lds, const int K, const Sched& S, const Epi& E) {
    const int tid = threadIdx.x, wid = __builtin_amdgcn_readfirstlane(tid >> 6), lane = tid & 63, wr = wid >> 2, wc = wid & 3, fr = lane & 15, fq = lane >> 4;
    const int nt = K / BK;
    unsigned voffA[2], voffB[2];
#pragma unroll
    for (int i = 0; i < 2; ++i) { int R, C; stage_rc(tid * 16 + i * 8192, R, C); const int Rb = Epi::PERM ? ((R & ~31) + perm32(R & 31)) : R;
        voffA[i] = (unsigned)(R * K + C) * 2u; voffB[i] = (unsigned)(Rb * K + C) * 2u; }
    const size_t kstep = (size_t)(BK * 2);
    const size_t hstep = (size_t)HALF * K * 2;
    const unsigned ldsw = (unsigned)wid * 1024u;
    const int aoff = lds_byte(wr * 64 + fr, fq * 8), boff = lds_byte(wc * 32 + fr, fq * 8);
#define PG8_SA(b, h) (((b) * 2 + (h)) * HTB)
#define PG8_SB(b, h) ((4 + (b) * 2 + (h)) * HTB)
#define PG8_STAGE(bufoff, gbase, voff) do { _Pragma("unroll") for (int _i = 0; _i < 2; ++_i) \
        __builtin_amdgcn_global_load_lds((const unsigned*)((const char*)(gbase) + (voff)[_i]), (LAS unsigned*)(lds + (bufoff) + ldsw + _i * 8192), 16, 0, 0); } while (0)
#define PG8_LDA(dst, b, h) do { _Pragma("unroll") for (int m = 0; m < 4; ++m) _Pragma("unroll") for (int k = 0; k < 2; ++k) dst[m][k] = *(const LAS bf16x8*)(lds + PG8_SA(b, h) + aoff + m * 2048 + k * 1024); } while (0)
#define PG8_LDB(dst, b, h) do { _Pragma("unroll") for (int n = 0; n < 2; ++n) _Pragma("unroll") for (int k = 0; k < 2; ++k) dst[n][k] = *(const LAS bf16x8*)(lds + PG8_SB(b, h) + boff + n * 2048 + k * 1024); } while (0)
#define PG8_MMA(ai, bj, At, Bt) do { __builtin_amdgcn_s_setprio(1); _Pragma("unroll") for (int m = 0; m < 4; ++m) _Pragma("unroll") for (int n = 0; n < 2; ++n) _Pragma("unroll") for (int k = 0; k < 2; ++k) \
        acc[ai][bj][m][n] = __builtin_amdgcn_mfma_f32_16x16x32_bf16(Bt[n][k], At[m][k], acc[ai][bj][m][n], 0, 0, 0); __builtin_amdgcn_s_setprio(0); } while (0)
#define PG8_WAIT_V(n) asm volatile("s_waitcnt vmcnt(" #n ")" ::: "memory")
#define PG8_WAIT_L(n) asm volatile("s_waitcnt lgkmcnt(" #n ")" ::: "memory")
#define PG8_BAR __builtin_amdgcn_s_barrier()
#define PG8_SCHED __builtin_amdgcn_sched_barrier(0)
    Unit cur, nxt; int ui = 0;
    if (!S.next(0, cur)) return;
    f32x4 acc[2][2][4][2];
#pragma unroll
    for (int a = 0; a < 2; ++a)
#pragma unroll
        for (int b = 0; b < 2; ++b)
#pragma unroll
            for (int m = 0; m < 4; ++m)
#pragma unroll
                for (int n = 0; n < 2; ++n) acc[a][b][m][n] = (f32x4){0.f, 0.f, 0.f, 0.f};
    bf16x8 At[4][2], B0[2][2], B1[2][2];
    const char* cA = cur.a; const char* cB = cur.b;
    PG8_STAGE(PG8_SB(0, 0), cB, voffB); PG8_STAGE(PG8_SB(0, 1), cB + hstep, voffB); PG8_STAGE(PG8_SA(0, 0), cA, voffA); PG8_STAGE(PG8_SA(0, 1), cA + hstep, voffA);
    if (wr == 1) PG8_BAR;
    PG8_WAIT_V(2); PG8_BAR;
    PG8_STAGE(PG8_SB(1, 0), cB + kstep, voffB); PG8_STAGE(PG8_SA(1, 0), cA + kstep, voffA); PG8_STAGE(PG8_SB(1, 1), cB + hstep + kstep, voffB);
    PG8_WAIT_V(6); PG8_BAR;
    for (;;) {
        const bool has_next = S.next(ui + 1, nxt);
        const char* nA = has_next ? nxt.a : cA; const char* nB = has_next ? nxt.b : cB;
        for (int t = 0; t < nt; t += 2) {
            const bool last = (t == nt - 2);
            const char* a1 = cA + (size_t)(t + 1) * kstep;
            const char* a2 = last ? nA : cA + (size_t)(t + 2) * kstep; const char* b2 = last ? nB : cB + (size_t)(t + 2) * kstep;
            const char* a3 = a2 + kstep; const char* b3 = b2 + kstep;
            PG8_LDB(B0, 0, 0); PG8_LDB(B1, 0, 1); PG8_SCHED; PG8_LDA(At, 0, 0); PG8_STAGE(PG8_SA(1, 1), a1 + hstep, voffA);
            PG8_WAIT_V(8); PG8_WAIT_L(0); PG8_BAR; PG8_MMA(0, 0, At, B0); PG8_MMA(0, 1, At, B1); PG8_BAR; PG8_SCHED;
            PG8_LDA(At, 0, 1); PG8_STAGE(PG8_SB(0, 0), b2, voffB); PG8_STAGE(PG8_SB(0, 1), b2 + hstep, voffB); PG8_STAGE(PG8_SA(0, 0), a2, voffA);
            PG8_WAIT_V(8); PG8_WAIT_L(0); PG8_BAR; PG8_MMA(1, 0, At, B0); PG8_MMA(1, 1, At, B1); PG8_BAR; PG8_SCHED;
            PG8_LDB(B0, 1, 0); PG8_LDB(B1, 1, 1); PG8_SCHED; PG8_LDA(At, 1, 0); PG8_STAGE(PG8_SA(0, 1), a2 + hstep, voffA);
            PG8_WAIT_V(8); PG8_WAIT_L(0); PG8_BAR; PG8_MMA(0, 0, At, B0); PG8_MMA(0, 1, At, B1); PG8_BAR; PG8_SCHED;
            PG8_LDA(At, 1, 1); PG8_STAGE(PG8_SB(1, 0), b3, voffB); PG8_STAGE(PG8_SB(1, 1), b3 + hstep, voffB); PG8_STAGE(PG8_SA(1, 0), a3, voffA);
            PG8_WAIT_V(8); PG8_WAIT_L(0); PG8_BAR; PG8_MMA(1, 0, At, B0); PG8_MMA(1, 1, At, B1); PG8_BAR; PG8_SCHED;
        }
        if (wr == 0) PG8_BAR;
        E(acc, cur, wr, wc, fr, fq);
        if (!has_next) break;
#pragma unroll
        for (int a = 0; a < 2; ++a)
#pragma unroll
            for (int b = 0; b < 2; ++b)
#pragma unroll
                for (int m = 0; m < 4; ++m)
#pragma unroll
                    for (int n = 0; n < 2; ++n) acc[a][b][m][n] = (f32x4){0.f, 0.f, 0.f, 0.f};
        cur = nxt; cA = nA; cB = nB; ++ui;
        if (wr == 1) PG8_BAR;
    }
    PG8_WAIT_V(0);
    PG8_BAR;
#undef PG8_SA
#undef PG8_SB
#undef PG8_STAGE
#undef PG8_LDA
#undef PG8_LDB
#undef PG8_MMA
#undef PG8_WAIT_V
#undef PG8_WAIT_L
#undef PG8_BAR
#undef PG8_SCHED
}
}
using pg8::Unit;

#define XB_TMO      128
#define XB_XCNT(j)  (256  + 64 * (j))
#define XB_XSUB(j)  (1280 + 64 * (j))
#define XB_XGEN(j)  (2304 + 64 * (j))
#define XB_TOP      3328
#define XB_TOPGEN   3392
#define XCD_BAR_WORDS 3456
#define XB_SPIN_CAP (1u << 18)
__device__ __forceinline__ unsigned xb_ld(unsigned* p)              { return __hip_atomic_load(p, __ATOMIC_RELAXED, __HIP_MEMORY_SCOPE_AGENT); }
__device__ __forceinline__ unsigned xb_add(unsigned* p, unsigned v) { return __hip_atomic_fetch_add(p, v, __ATOMIC_RELAXED, __HIP_MEMORY_SCOPE_AGENT); }
__device__ __forceinline__ unsigned xb_xcc_id() { return (unsigned)__builtin_amdgcn_s_getreg((3 << 11) | 20) & 0xFu; }
#define XB_SPIN(cond, bar) do { unsigned _sp = 0; while (cond) { __builtin_amdgcn_s_sleep(1); \
    if ((++_sp & 255u) == 0u) { if (xb_ld(&(bar)[XB_TMO])) break; if (_sp > XB_SPIN_CAP) { atomicAdd(&(bar)[XB_TMO], 1u); break; } } } } while (0)
struct XcdBarrier { unsigned* bar; unsigned x; volatile LAS unsigned* st; };
__device__ __forceinline__ XcdBarrier xcd_barrier_post(unsigned* bar, volatile LAS unsigned* st) {
    XcdBarrier b; b.bar = bar; b.x = xb_xcc_id(); b.st = st;
    if (threadIdx.x == 0) (void)xb_add(&bar[XB_XCNT(b.x)], 1u);
    return b;
}
__device__ __forceinline__ void xcd_barrier_complete(unsigned* bar, unsigned x, unsigned& nloc, unsigned& nx) {
    const unsigned G = gridDim.x * gridDim.y * gridDim.z;
    unsigned sum, cnt, mine, sp = 0u;
    for (;;) {
        sum = 0u; cnt = 0u; mine = 0u;
#pragma unroll
        for (unsigned j = 0; j < 16; ++j) { const unsigned c = xb_ld(&bar[XB_XCNT(j)]); sum += c; cnt += (c > 0u) ? 1u : 0u; mine = (j == x) ? c : mine; }
        if (sum == G) break;
        __builtin_amdgcn_s_sleep(1);
        if ((++sp & 255u) == 0u) { if (xb_ld(&bar[XB_TMO])) break; if (sp > XB_SPIN_CAP) { atomicAdd(&bar[XB_TMO], 1u); break; } }
    }
    nloc = mine > 0u ? mine : 1u; nx = cnt > 0u ? cnt : 1u;
}
__device__ __forceinline__ void xcd_barrier(const XcdBarrier& b) {
    asm volatile("s_waitcnt vmcnt(0)" ::: "memory");
    __syncthreads();
    if (threadIdx.x == 0) {
        unsigned* bar = b.bar;
        __builtin_amdgcn_s_waitcnt(0);
        unsigned nloc = b.st[0], nx = b.st[1];
        if (nloc == 0u) { xcd_barrier_complete(bar, b.x, nloc, nx); b.st[0] = nloc; b.st[1] = nx; }
        const unsigned old = xb_add(&bar[XB_XSUB(b.x)], 1u);
        const unsigned gen = old / nloc;
        if (old + 1u == (gen + 1u) * nloc) {
            __builtin_amdgcn_fence(__ATOMIC_RELEASE, "agent");
            asm volatile("s_waitcnt vmcnt(0)" ::: "memory");
            const unsigned og = xb_add(&bar[XB_TOP], 1u);
            const unsigned tg = og / nx;
            if (og + 1u == (tg + 1u) * nx) xb_add(&bar[XB_TOPGEN], 1u);
            else XB_SPIN(xb_ld(&bar[XB_TOPGEN]) == tg, bar);
            __builtin_amdgcn_fence(__ATOMIC_ACQUIRE, "agent");
            xb_add(&bar[XB_XGEN(b.x)], 1u);
            asm volatile("s_waitcnt vmcnt(0)" ::: "memory");
        } else {
            XB_SPIN(xb_ld(&bar[XB_XGEN(b.x)]) == gen, bar);
            __builtin_amdgcn_fence(__ATOMIC_ACQUIRE, "agent");
            asm volatile("s_waitcnt vmcnt(0)" ::: "memory");
        }
    }
    __syncthreads();
}

struct Args {
    const float* in[34];
    float* out;
    unsigned char* ws;
    int ph_lo, ph_hi;
};

enum { I_X = 0, I_C, I_RELB, I_EADAW, I_EADAB, I_EN1, I_EINW, I_EQN, I_EKN, I_ESINK, I_EOUTW, I_EN2, I_EF1, I_EF3, I_EF2,
       I_OADAW, I_OADAB, I_ON1, I_OINW, I_OCONVW, I_OCONVB, I_ODTBF, I_ODTBB, I_OALF, I_OALB, I_OD, I_OGN, I_OOUTW, I_ON2, I_ORW, I_ORB, I_OM1, I_OM3, I_OM2 };

struct Frame {
    LAS unsigned char* lds;
    unsigned char* ws;
    int tid, lane, wave, G, vcu;
};

__device__ __forceinline__ void tr_item(const float* src  , int srcN, int k0, int n0, bf16* dstrow  , int dstK, LAS float* scr, int lane) {
#pragma unroll 8
    for (int i = 0; i < 32; ++i) { const int kk = 2 * i + (lane >> 5); scr[kk * 33 + (lane & 31)] = src[(size_t)(k0 + kk) * srcN + n0 + (lane & 31)]; }
    LDS_WAIT(); asm volatile("" ::: "memory");
    const int c = lane & 7;
#pragma unroll
    for (int j = 0; j < 4; ++j) { const int n = (lane >> 3) + 8 * j; const LAS float* s = scr + (8 * c) * 33 + n;
        u32x4 o; o.x = pk2(s[0 * 33], s[1 * 33]); o.y = pk2(s[2 * 33], s[3 * 33]); o.z = pk2(s[4 * 33], s[5 * 33]); o.w = pk2(s[6 * 33], s[7 * 33]);
        *(u32x4*)(dstrow + (size_t)n * dstK + k0 + 8 * c) = o; }
    LDS_WAIT(); asm volatile("" ::: "memory");
}

__device__ __forceinline__ void p0_prologue(const Frame& F, const Args& A) {
    const int tid = F.tid, lane = F.lane, wave = F.wave;
    unsigned char* ws = F.ws;
    if (blockIdx.x < 128) {
        const int it = blockIdx.x, kb = it & 15, part = (it >> 4) & 1, g = it >> 5;
        LAS float* tile = (LAS float*)F.lds;
        LAS float* ctab = (LAS float*)(F.lds + 32768);
        const float* Win = A.in[I_EINW];
        for (int i = tid; i < 64 * 128; i += 512) { const int kk = i >> 7, c = i & 127; tile[i] = Win[(size_t)(kb * 64 + kk) * 1280 + g * 128 + c]; }
        if (tid < 128) { const float ang = (float)tid * (6.283185307179586f / 128.0f); ctab[tid] = (part ? sinf(ang) : cosf(ang)) * 0.08838834764831845f; }
        __syncthreads();
        const int m = tid & 127, kq = tid >> 7;
        float accv[16];
#pragma unroll
        for (int j = 0; j < 16; ++j) accv[j] = 0.f;
        for (int c = 0; c < 128; ++c) { const float w = ctab[(m * c) & 127];
#pragma unroll
            for (int j = 0; j < 16; ++j) accv[j] += tile[(kq * 16 + j) * 128 + c] * w; }
        bf16* WU = (bf16*)(ws + WS_WU);
        u32x4 o0, o1;
        o0.x = pk2(accv[0], accv[1]); o0.y = pk2(accv[2], accv[3]); o0.z = pk2(accv[4], accv[5]); o0.w = pk2(accv[6], accv[7]);
        o1.x = pk2(accv[8], accv[9]); o1.y = pk2(accv[10], accv[11]); o1.z = pk2(accv[12], accv[13]); o1.w = pk2(accv[14], accv[15]);
        bf16* dst = WU + (size_t)(part * 512 + g * 128 + m) * 1024 + kb * 64 + kq * 16;
        *(u32x4*)dst = o0; *(u32x4*)(dst + 8) = o1;
        __syncthreads();
    }
    {
        LAS float* ct = (LAS float*)F.lds;
        for (int j = tid; j < 2048; j += 512) ct[j] = cosf((float)j * (6.283185307179586f / 2048.0f)) * 0.022097086912079608f;
        __syncthreads();
        bf16* FD = (bf16*)(ws + WS_FDFT);
        const int nchunk = 2048 * 4096 / 8;
        for (int ch = blockIdx.x * 512 + tid; ch < nchunk; ch += F.G * 512) {
            const int k = ch >> 9, c0 = (ch & 511) * 8;
            float v[8];
#pragma unroll
            for (int e = 0; e < 8; ++e) { const int cc = c0 + e; if (cc < 2048) v[e] = ct[(k * cc) & 2047]; else v[e] = -ct[((k * (cc - 2048)) - 512) & 2047]; }
            u32x4 o; o.x = pk2(v[0], v[1]); o.y = pk2(v[2], v[3]); o.z = pk2(v[4], v[5]); o.w = pk2(v[6], v[7]);
            *(u32x4*)(FD + (size_t)k * 4096 + c0) = o;
        }
        __syncthreads();
    }
    const int gw = F.vcu * 8 + wave, NGW = F.G * 8;
    {
        float* MODP = (float*)(ws + WS_MODP);
        for (int it = gw; it < 192 * 16; it += NGW) {
            const int cg = it % 192, ks = it / 192, l = cg / 96, col = (cg % 96) * 64 + lane;
            const float* W = A.in[l ? I_OADAW : I_EADAW];
            float cs[8], acc8[8];
#pragma unroll
            for (int b = 0; b < 8; ++b) { cs[b] = siluf(A.in[I_C][b * 1024 + ks * 64 + lane]); acc8[b] = 0.f; }
#pragma unroll 8
            for (int kk = 0; kk < 64; ++kk) { const float w = W[(size_t)(ks * 64 + kk) * 6144 + col];
#pragma unroll
                for (int b = 0; b < 8; ++b) acc8[b] += __shfl(cs[b], kk) * w; }
#pragma unroll
            for (int b = 0; b < 8; ++b) MODP[(size_t)ks * 98304 + l * 49152 + b * 6144 + col] = acc8[b];
        }
    }
    {
        LAS float* scr = (LAS float*)(F.lds + wave * 16384);
        constexpr int N1 = 16 * 24, N2 = 16 * 32, N3 = 16 * 88, N5 = 44 * 32, N6 = 16 * 162, N7 = 32 * 32, N8 = 8 * 16 * 112, N10 = 8 * 56 * 32;
        constexpr int NIT = N1 + N2 + 2 * N3 + N5 + N6 + N7 + 2 * N8 + N10;
        for (int it = gw; it < NIT; it += NGW) {
            int r = it;
            if (r < N1) { const int kb = r / 24, nb = r % 24; tr_item(A.in[I_EINW] + 512, 1280, kb * 64, nb * 32, (bf16*)(ws + WS_WQKV) + (size_t)(nb * 32) * 1024, 1024, scr, lane); continue; } r -= N1;
            if (r < N2) { const int kb = r / 32, nb = r % 32; tr_item(A.in[I_EOUTW], 1024, kb * 64, nb * 32, (bf16*)(ws + WS_WO0) + (size_t)(nb * 32) * 1024, 1024, scr, lane); continue; } r -= N2;
            if (r < 2 * N3) { const int w3 = r >= N3; if (w3) r -= N3; const int kb = r / 88, nb = r % 88, n0 = nb * 32, drow = (n0 >> 7) * 256 + (n0 & 127) + (w3 ? 128 : 0);
                tr_item(A.in[w3 ? I_EF3 : I_EF1], DFF, kb * 64, n0, (bf16*)(ws + WS_WF13) + (size_t)drow * 1024, 1024, scr, lane); continue; } r -= 2 * N3;
            if (r < N5) { const int kb = r / 32, nb = r % 32; tr_item(A.in[I_EF2], 1024, kb * 64, nb * 32, (bf16*)(ws + WS_WF2) + (size_t)(nb * 32) * DFF, DFF, scr, lane); continue; } r -= N5;
            if (r < N6) { const int kb = r / 162, nb = r % 162; tr_item(A.in[I_OINW], 5184, kb * 64, nb * 32, (bf16*)(ws + WS_WSIN) + (size_t)(nb * 32) * 1024, 1024, scr, lane); continue; } r -= N6;
            if (r < N7) { const int kb = r / 32, nb = r % 32; tr_item(A.in[I_OOUTW], 1024, kb * 64, nb * 32, (bf16*)(ws + WS_WSOUT) + (size_t)(nb * 32) * 2048, 2048, scr, lane); continue; } r -= N7;
            if (r < 2 * N8) { const int w3 = r >= N8; if (w3) r -= N8; const int e = r / (16 * 112); r %= 16 * 112; const int kb = r / 112, nb = r % 112, n0 = nb * 32, drow = (n0 >> 7) * 256 + (n0 & 127) + (w3 ? 128 : 0);
                tr_item(A.in[w3 ? I_OM3 : I_OM1] + (size_t)e * 1024 * DFE, DFE, kb * 64, n0, (bf16*)(ws + WS_WM13) + ((size_t)e * 7168 + drow) * 1024, 1024, scr, lane); continue; } r -= 2 * N8;
            { const int e = r / (56 * 32); r %= 56 * 32; const int kb = r / 32, nb = r % 32;
                tr_item(A.in[I_OM2] + (size_t)e * DFE * 1024, 1024, kb * 64, nb * 32, (bf16*)(ws + WS_WM2) + ((size_t)e * 1024 + nb * 32) * DFE, DFE, scr, lane); }
        }
    }
}

template <int MODE>
__device__ __forceinline__ void modulate_phase(const Frame& F, const Args& A, const float* xsrc, const float* normw, int layer, int which  ) {
    const int tid = F.tid, lane = F.lane, wave = F.wave;
    unsigned char* ws = F.ws;
    LAS float* sh = (LAS float*)F.lds;
    LAS float* sc = sh + 1024;
    LAS float* nw = sc + 1024;
    LAS float* rw = nw + 1024;
    LAS int* lcnt = (LAS int*)(rw + 8192);
    LAS int* gbase = lcnt + 8;
    LAS int* sel_e = gbase + 8;
    LAS int* sel_p = sel_e + 128;
    LAS float* sel_w = (LAS float*)(sel_p + 128);
    const float* MODP = (const float*)(ws + WS_MODP);
    float* MOD = (float*)(ws + WS_MOD);
    bf16* XN = (bf16*)(ws + WS_XN);
    for (int blk = blockIdx.x; blk < T / 64; blk += F.G) {
        const int row0 = blk * 64, b = row0 / SEQ;
        __syncthreads();
        for (int i = tid; i < 2048; i += 512) {
            const int idx = layer * 49152 + b * 6144 + which * 3072 + i;
            float v;
            if (MODE == 0) { v = A.in[I_EADAB][which * 3072 + i];
#pragma unroll
                for (int ks = 0; ks < 16; ++ks) v += MODP[(size_t)ks * 98304 + idx]; }
            else v = MOD[idx];
            sh[i] = v;
        }
        for (int i = tid; i < 1024; i += 512) nw[i] = normw[i];
        if (MODE == 2) { for (int i = tid; i < 8192; i += 512) { const int e = i >> 10, c = i & 1023; rw[i] = A.in[I_ORW][c * 8 + e]; } if (tid < 8) lcnt[tid] = 0; }
        __syncthreads();
        for (int rr = 0; rr < 8; ++rr) {
            const int lr = wave * 8 + rr, row = row0 + lr;
            const GAS f32x4* xr = (const GAS f32x4*)(xsrc + (size_t)row * D) + lane;
            f32x4 v[4]; float ss = 0.f;
#pragma unroll
            for (int j = 0; j < 4; ++j) { v[j] = xr[64 * j]; ss += (v[j].x * v[j].x + v[j].y * v[j].y) + (v[j].z * v[j].z + v[j].w * v[j].w); }
            const float rstd = 1.0f / sqrtf(wave_sum(ss) * (1.0f / D) + EPS);
            GAS unsigned long long* o8 = (GAS unsigned long long*)(XN + (size_t)row * D) + lane;
            float lg[8];
            if (MODE == 2) {
#pragma unroll
                for (int e = 0; e < 8; ++e) lg[e] = 0.f; }
#pragma unroll
            for (int j = 0; j < 4; ++j) {
                const int c = 4 * lane + 256 * j;
                const f32x4 w4 = *(const LAS f32x4*)(nw + c), s4 = *(const LAS f32x4*)(sc + c), h4 = *(const LAS f32x4*)(sh + c);
                f32x4 y;
                y.x = v[j].x * rstd * w4.x * (1.0f + s4.x) + h4.x; y.y = v[j].y * rstd * w4.y * (1.0f + s4.y) + h4.y;
                y.z = v[j].z * rstd * w4.z * (1.0f + s4.z) + h4.z; y.w = v[j].w * rstd * w4.w * (1.0f + s4.w) + h4.w;
                o8[64 * j] = (unsigned long long)pk2(y.x, y.y) | ((unsigned long long)pk2(y.z, y.w) << 32);
                if (MODE == 2) {
#pragma unroll
                    for (int e = 0; e < 8; ++e) { const f32x4 r4 = *(const LAS f32x4*)(rw + e * 1024 + c); lg[e] += (y.x * r4.x + y.y * r4.y) + (y.z * r4.z + y.w * r4.w); } }
            }
            if (MODE == 2) {
#pragma unroll
                for (int e = 0; e < 8; ++e) lg[e] = wave_sum(lg[e]) + A.in[I_ORB][e];
                int i0 = 0; float v0 = lg[0];
#pragma unroll
                for (int e = 1; e < 8; ++e) if (lg[e] > v0) { v0 = lg[e]; i0 = e; }
                int i1 = -1; float v1 = -3.0e38f;
#pragma unroll
                for (int e = 0; e < 8; ++e) if (e != i0 && lg[e] > v1) { v1 = lg[e]; i1 = e; }
                const float w0 = 1.0f / (1.0f + __expf(v1 - v0)), w1 = 1.0f - w0;
                if (lane == 0) {
                    sel_e[lr * 2] = i0; sel_e[lr * 2 + 1] = i1; sel_w[lr * 2] = w0; sel_w[lr * 2 + 1] = w1;
                    sel_p[lr * 2] = __hip_atomic_fetch_add(lcnt + i0, 1, __ATOMIC_RELAXED, __HIP_MEMORY_SCOPE_WORKGROUP);
                    sel_p[lr * 2 + 1] = __hip_atomic_fetch_add(lcnt + i1, 1, __ATOMIC_RELAXED, __HIP_MEMORY_SCOPE_WORKGROUP);
                }
            }
        }
        if (MODE == 2) {
            __syncthreads();
            unsigned* gcnt = (unsigned*)(ws + WS_CTL) + CW_GCNT;
            if (tid < 8) gbase[tid] = (int)__hip_atomic_fetch_add(gcnt + tid, (unsigned)lcnt[tid], __ATOMIC_RELAXED, __HIP_MEMORY_SCOPE_AGENT);
            __syncthreads();
            if (tid < 128) { const int tok = row0 + (tid >> 1), k = tid & 1, e = sel_e[tid];
                ((int*)(ws + WS_ROUTE + RT_TOKE))[tok * 2 + k] = e;
                ((int*)(ws + WS_ROUTE + RT_TOKP))[tok * 2 + k] = gbase[e] + sel_p[tid];
                ((float*)(ws + WS_ROUTE + RT_TOKW))[tok * 2 + k] = sel_w[tid]; }
        }
    }
    if (MODE == 0) {
        const int idx = blockIdx.x * 384 + tid;
        if (tid < 384 && idx < 98304) { const int l = idx / 49152, col = idx % 6144; float v = A.in[l ? I_OADAB : I_EADAB][col];
#pragma unroll
            for (int ks = 0; ks < 16; ++ks) v += MODP[(size_t)ks * 98304 + idx];
            MOD[idx] = v; }
    }
}

struct SchedPlain {
    const char* A; const char* B; int nM, nN, G, c; size_t tstep;
    __device__ __forceinline__ bool next(int i, Unit& u) const { int pm, pn; if (!pg8::tile_order(i, G, c, nM, nN, pm, pn)) return false; u.pm = pm; u.pn = pn; u.a = A + (size_t)pm * tstep; u.b = B + (size_t)pn * tstep; return true; }
};
struct SchedFourier {
    const char* Fm; const char* UT; int unit;
    __device__ __forceinline__ bool next(int i, Unit& u) const { if (i != 0 || unit < 0) return false; const int b = unit >> 4, idx = unit & 15; u.pm = b * 8 + (idx & 7); u.pn = idx >> 3;
        u.a = Fm + (size_t)(idx & 7) * 256 * 4096 * 2; u.b = UT + ((size_t)b * 512 + (size_t)(idx >> 3) * 256) * 4096 * 2; return true; }
};
struct SchedMoe {
    const char* A; const char* B; const LAS int* pexp; int nM, nN, G, c; size_t tstepA, tstepB; int tiles_per_exp;
    __device__ __forceinline__ bool next(int i, Unit& u) const { int pm, pn; if (!pg8::tile_order(i, G, c, nM, nN, pm, pn)) return false; u.pm = pm; u.pn = pn; const int e = pexp[pm];
        u.a = A + (size_t)pm * tstepA; u.b = B + (size_t)(e * tiles_per_exp + pn) * tstepB; return true; }
};

struct EpiBf16 {
    static constexpr bool PERM = true;
    bf16* O; int ldc;
    __device__ __forceinline__ void operator()(const f32x4 (&acc)[2][2][4][2], const Unit& u, int wr, int wc, int fr, int fq) const {
        const int row0 = u.pm * 256 + wr * 64 + fr, col0 = u.pn * 256 + wc * 32 + 8 * fq;
#pragma unroll
        for (int ai = 0; ai < 2; ++ai)
#pragma unroll
            for (int m = 0; m < 4; ++m) { bf16* rowp = O + (size_t)(row0 + ai * 128 + m * 16) * ldc + col0;
#pragma unroll
                for (int bj = 0; bj < 2; ++bj) { const f32x4 v0 = acc[ai][bj][m][0], v1 = acc[ai][bj][m][1];
                    u32x4 w; w.x = pk2(v0[0], v0[1]); w.y = pk2(v0[2], v0[3]); w.z = pk2(v1[0], v1[1]); w.w = pk2(v1[2], v1[3]);
                    *(u32x4*)(rowp + bj * 128) = w; } }
    }
};
struct EpiUT {
    static constexpr bool PERM = true;
    bf16* UT;
    __device__ __forceinline__ void operator()(const f32x4 (&acc)[2][2][4][2], const Unit& u, int wr, int wc, int fr, int fq) const {
        const int part = u.pm >> 1, c0 = (u.pm & 1) * 256 + wr * 64 + fr, b = u.pn >> 3, s0 = (u.pn & 7) * 256 + wc * 32 + 8 * fq;
        bf16* base = UT + ((size_t)b * 512) * 4096 + part * 2048 + s0;
#pragma unroll
        for (int ai = 0; ai < 2; ++ai)
#pragma unroll
            for (int m = 0; m < 4; ++m) { bf16* rowp = base + (size_t)(c0 + ai * 128 + m * 16) * 4096;
#pragma unroll
                for (int bj = 0; bj < 2; ++bj) { const f32x4 v0 = acc[ai][bj][m][0], v1 = acc[ai][bj][m][1];
                    u32x4 w; w.x = pk2(v0[0], v0[1]); w.y = pk2(v0[2], v0[3]); w.z = pk2(v1[0], v1[1]); w.w = pk2(v1[2], v1[3]);
                    *(u32x4*)(rowp + bj * 128) = w; } }
    }
};
struct EpiRes {
    static constexpr bool PERM = false;
    const float* base; float* out; const float* g;
    __device__ __forceinline__ void operator()(const f32x4 (&acc)[2][2][4][2], const Unit& u, int wr, int wc, int fr, int fq) const {
        const int row0 = u.pm * 256 + wr * 64 + fr, col0 = u.pn * 256 + wc * 32 + 4 * fq, b = (u.pm * 256) / SEQ;
        f32x4 gv[2][2];
#pragma unroll
        for (int bj = 0; bj < 2; ++bj)
#pragma unroll
            for (int n = 0; n < 2; ++n) gv[bj][n] = *(const f32x4*)(g + b * 6144 + col0 + bj * 128 + n * 16);
#pragma unroll
        for (int ai = 0; ai < 2; ++ai)
#pragma unroll
            for (int m = 0; m < 4; ++m) { const size_t off = (size_t)(row0 + ai * 128 + m * 16) * D + col0;
#pragma unroll
                for (int bj = 0; bj < 2; ++bj)
#pragma unroll
                    for (int n = 0; n < 2; ++n) { const f32x4 bs = *(const f32x4*)(base + off + bj * 128 + n * 16);
                        *(f32x4*)(out + off + bj * 128 + n * 16) = bs + gv[bj][n] * acc[ai][bj][m][n]; } }
    }
};
struct EpiSwiglu {
    static constexpr bool PERM = true;
    bf16* H; int ldc;
    __device__ __forceinline__ void operator()(const f32x4 (&acc)[2][2][4][2], const Unit& u, int wr, int wc, int fr, int fq) const {
        const int row0 = u.pm * 256 + wr * 64 + fr, col0 = u.pn * 128 + wc * 32 + 8 * fq;
#pragma unroll
        for (int ai = 0; ai < 2; ++ai)
#pragma unroll
            for (int m = 0; m < 4; ++m) { bf16* rowp = H + (size_t)(row0 + ai * 128 + m * 16) * ldc + col0;
                float h[8];
#pragma unroll
                for (int n = 0; n < 2; ++n)
#pragma unroll
                    for (int j = 0; j < 4; ++j) { const float a = acc[ai][0][m][n][j], bb = acc[ai][1][m][n][j]; h[n * 4 + j] = a / (1.0f + __expf(-a)) * bb; }
                u32x4 w; w.x = pk2(h[0], h[1]); w.y = pk2(h[2], h[3]); w.z = pk2(h[4], h[5]); w.w = pk2(h[6], h[7]);
                *(u32x4*)rowp = w; }
    }
};
struct EpiSsmIn {
    static constexpr bool PERM = true;
    bf16* Z; bf16* XBC;
    __device__ __forceinline__ void operator()(const f32x4 (&acc)[2][2][4][2], const Unit& u, int wr, int wc, int fr, int fq) const {
        const int row0 = u.pm * 256 + wr * 64 + fr; const bool isz = u.pn < 8;
        bf16* O = isz ? Z : XBC; const int ldc = isz ? 2048 : 3072, col0 = (isz ? u.pn : u.pn - 8) * 256 + wc * 32 + 8 * fq;
#pragma unroll
        for (int ai = 0; ai < 2; ++ai)
#pragma unroll
            for (int m = 0; m < 4; ++m) { bf16* rowp = O + (size_t)(row0 + ai * 128 + m * 16) * ldc + col0;
#pragma unroll
                for (int bj = 0; bj < 2; ++bj) { const f32x4 v0 = acc[ai][bj][m][0], v1 = acc[ai][bj][m][1];
                    u32x4 w; w.x = pk2(v0[0], v0[1]); w.y = pk2(v0[2], v0[3]); w.z = pk2(v1[0], v1[1]); w.w = pk2(v1[2], v1[3]);
                    *(u32x4*)(rowp + bj * 128) = w; } }
    }
};
struct EpiMoeSlot {
    static constexpr bool PERM = true;
    bf16* YS; const int* rowdst;
    __device__ __forceinline__ void operator()(const f32x4 (&acc)[2][2][4][2], const Unit& u, int wr, int wc, int fr, int fq) const {
        const int row0 = u.pm * 256 + wr * 64 + fr, col0 = u.pn * 256 + wc * 32 + 8 * fq;
#pragma unroll
        for (int ai = 0; ai < 2; ++ai)
#pragma unroll
            for (int m = 0; m < 4; ++m) { const int dst = rowdst[row0 + ai * 128 + m * 16];
                if (dst >= 0) { bf16* rowp = YS + (size_t)dst * D + col0;
#pragma unroll
                    for (int bj = 0; bj < 2; ++bj) { const f32x4 v0 = acc[ai][bj][m][0], v1 = acc[ai][bj][m][1];
                        u32x4 w; w.x = pk2(v0[0], v0[1]); w.y = pk2(v0[2], v0[3]); w.z = pk2(v1[0], v1[1]); w.w = pk2(v1[2], v1[3]);
                        *(u32x4*)(rowp + bj * 128) = w; } } }
    }
};

__device__ __forceinline__ int t5_bucket(int rel) {
    const int n = rel < 0 ? -rel : rel;
    int v = n < 8 ? n : n < 12 ? 8 : n < 16 ? 9 : n < 23 ? 10 : n < 32 ? 11 : n < 46 ? 12 : n < 64 ? 13 : n < 91 ? 14 : 15;
    return (rel > 0 ? 16 : 0) + v;
}
__device__ __forceinline__ void attn_unit(const Frame& F, const Args& A, int b, int nb, int kvh) {
    const int tid = F.tid, lane = F.lane, wave = F.wave, l31 = lane & 31, hh = lane >> 5;
    LAS bf16* Kn = (LAS bf16*)F.lds;
    LAS bf16* VT = (LAS bf16*)(F.lds + 55296);
    LAS float* btab = (LAS float*)(F.lds + 55296 + 50176);
    const bf16* QKV = (const bf16*)(F.ws + WS_QKV);
    bf16* Y = (bf16*)(F.ws + WS_Y0);
    __syncthreads();
    for (int i = 0; i < 6; ++i) {
        const int cid = tid + 512 * i, j = cid >> 3, ch = cid & 7, kpos = nb * 128 - 128 + j;
        const bool ok = kpos >= 0 && kpos < SEQ;
        u32x4 kv = (u32x4){0u, 0u, 0u, 0u}, vv = kv;
        if (ok) { const bf16* rowp = QKV + (size_t)(b * SEQ + kpos) * QKVW; kv = *(const u32x4*)(rowp + 512 + kvh * 64 + ch * 8); vv = *(const u32x4*)(rowp + 640 + kvh * 64 + ch * 8); }
        float kf[8] = {bflo(kv.x), bfhi(kv.x), bflo(kv.y), bfhi(kv.y), bflo(kv.z), bfhi(kv.z), bflo(kv.w), bfhi(kv.w)};
        float ss = 0.f;
#pragma unroll
        for (int e = 0; e < 8; ++e) ss += kf[e] * kf[e];
        ss += __shfl_xor(ss, 1); ss += __shfl_xor(ss, 2); ss += __shfl_xor(ss, 4);
        const float rstd = 1.0f / sqrtf(ss * (1.0f / 64.0f) + EPS);
        const float* kw = A.in[I_EKN] + ch * 8;
        u32x4 o; o.x = pk2(kf[0] * rstd * kw[0], kf[1] * rstd * kw[1]); o.y = pk2(kf[2] * rstd * kw[2], kf[3] * rstd * kw[3]);
        o.z = pk2(kf[4] * rstd * kw[4], kf[5] * rstd * kw[5]); o.w = pk2(kf[6] * rstd * kw[6], kf[7] * rstd * kw[7]);
        *(LAS u32x4*)(Kn + j * 72 + ch * 8) = o;
        const unsigned vw[4] = {vv.x, vv.y, vv.z, vv.w};
#pragma unroll
        for (int e = 0; e < 8; ++e) VT[(ch * 8 + e) * 392 + j] = (bf16)((e & 1) ? (vw[e >> 1] >> 16) : (vw[e >> 1] & 0xffffu));
    }
    for (int i = tid; i < 4 * 257; i += 512) { const int hq = i / 257, ri = i % 257; btab[hq * 260 + ri] = A.in[I_RELB][t5_bucket(ri - 128) * 8 + kvh * 4 + hq]; }
    __syncthreads();
    for (int itn = 0; itn < 2; ++itn) {
        const int it = wave + 8 * itn, hq = it >> 2, rb = it & 3, head = kvh * 4 + hq;
        const int qi = 32 * rb + l31, tok = b * SEQ + nb * 128 + qi;
        bf16x8 Qf[4];
        {
            u32x4 qv[4]; float ss = 0.f;
#pragma unroll
            for (int ks = 0; ks < 4; ++ks) { qv[ks] = *(const u32x4*)(QKV + (size_t)tok * QKVW + head * 64 + 16 * ks + 8 * hh);
                const unsigned w[4] = {qv[ks].x, qv[ks].y, qv[ks].z, qv[ks].w};
#pragma unroll
                for (int e = 0; e < 4; ++e) { const float a = bflo(w[e]), c = bfhi(w[e]); ss += a * a + c * c; } }
            ss += __shfl_xor(ss, 32);
            const float rstd = 0.125f / sqrtf(ss * (1.0f / 64.0f) + EPS);
#pragma unroll
            for (int ks = 0; ks < 4; ++ks) { const float* qw = A.in[I_EQN] + 16 * ks + 8 * hh; const unsigned w[4] = {qv[ks].x, qv[ks].y, qv[ks].z, qv[ks].w};
                u32x4 o; o.x = pk2(bflo(w[0]) * rstd * qw[0], bfhi(w[0]) * rstd * qw[1]); o.y = pk2(bflo(w[1]) * rstd * qw[2], bfhi(w[1]) * rstd * qw[3]);
                o.z = pk2(bflo(w[2]) * rstd * qw[4], bfhi(w[2]) * rstd * qw[5]); o.w = pk2(bflo(w[3]) * rstd * qw[6], bfhi(w[3]) * rstd * qw[7]);
                Qf[ks] = __builtin_bit_cast(bf16x8, o); }
        }
        float mrun = A.in[I_ESINK][head], lsum = hh ? 0.f : 1.0f;
        f32x16 O0, O1;
#pragma unroll
        for (int r = 0; r < 16; ++r) { O0[r] = 0.f; O1[r] = 0.f; }
        for (int tg = 0; tg < 3; ++tg) {
            f32x16 Sa[3];
#pragma unroll
            for (int kt = 0; kt < 3; ++kt) { const int jt = rb + 3 * tg + kt;
#pragma unroll
                for (int r = 0; r < 16; ++r) Sa[kt][r] = 0.f;
#pragma unroll
                for (int ks = 0; ks < 4; ++ks) { const bf16x8 kfr = *(const LAS bf16x8*)(Kn + (32 * jt + l31) * 72 + 16 * ks + 8 * hh);
                    Sa[kt] = __builtin_amdgcn_mfma_f32_32x32x16_bf16(kfr, Qf[ks], Sa[kt], 0, 0, 0); } }
            float gmax = -3.0e38f;
#pragma unroll
            for (int kt = 0; kt < 3; ++kt) { const int jt = rb + 3 * tg + kt;
#pragma unroll
                for (int r = 0; r < 16; ++r) { const int j = 32 * jt + (r & 3) + 8 * (r >> 2) + 4 * hh, rel = j - 128 - qi, kpos = nb * 128 - 128 + j;
                    const bool ok = rel >= -128 && rel <= 128 && kpos >= 0 && kpos < SEQ;
                    const int ridx = ok ? rel + 128 : 0;
                    const float s = ok ? Sa[kt][r] + btab[hq * 260 + ridx] : -INFINITY;
                    Sa[kt][r] = s; gmax = fmaxf(gmax, s); } }
            gmax = fmaxf(gmax, __shfl_xor(gmax, 32));
            const float mnew = fmaxf(mrun, gmax), alpha = __expf(mrun - mnew); mrun = mnew;
            float psum = 0.f;
#pragma unroll
            for (int kt = 0; kt < 3; ++kt)
#pragma unroll
                for (int r = 0; r < 16; ++r) { const float p = __expf(Sa[kt][r] - mnew); Sa[kt][r] = p; psum += p; }
            lsum = lsum * alpha + psum;
#pragma unroll
            for (int r = 0; r < 16; ++r) { O0[r] *= alpha; O1[r] *= alpha; }
#pragma unroll
            for (int kt = 0; kt < 3; ++kt) { const int jt = rb + 3 * tg + kt;
#pragma unroll
                for (int s2 = 0; s2 < 2; ++s2) {
                    u32x4 pw; pw.x = pk2(Sa[kt][8 * s2 + 0], Sa[kt][8 * s2 + 1]); pw.y = pk2(Sa[kt][8 * s2 + 2], Sa[kt][8 * s2 + 3]);
                    pw.z = pk2(Sa[kt][8 * s2 + 4], Sa[kt][8 * s2 + 5]); pw.w = pk2(Sa[kt][8 * s2 + 6], Sa[kt][8 * s2 + 7]);
                    const bf16x8 pf = __builtin_bit_cast(bf16x8, pw);
                    const int kb = 32 * jt + 16 * s2 + 4 * hh;
                    { const u32x2 lo = *(const LAS u32x2*)(VT + l31 * 392 + kb), hi = *(const LAS u32x2*)(VT + l31 * 392 + kb + 8);
                      const u32x4 vw = (u32x4){lo.x, lo.y, hi.x, hi.y}; O0 = __builtin_amdgcn_mfma_f32_32x32x16_bf16(__builtin_bit_cast(bf16x8, vw), pf, O0, 0, 0, 0); }
                    { const u32x2 lo = *(const LAS u32x2*)(VT + (32 + l31) * 392 + kb), hi = *(const LAS u32x2*)(VT + (32 + l31) * 392 + kb + 8);
                      const u32x4 vw = (u32x4){lo.x, lo.y, hi.x, hi.y}; O1 = __builtin_amdgcn_mfma_f32_32x32x16_bf16(__builtin_bit_cast(bf16x8, vw), pf, O1, 0, 0, 0); }
                } }
        }
        lsum += __shfl_xor(lsum, 32);
        const float inv = 1.0f / lsum;
        bf16* yrow = Y + (size_t)tok * D + 512 + head * 64;
#pragma unroll
        for (int q4 = 0; q4 < 4; ++q4) {
            u32x2 w0, w1;
            w0.x = pk2(O0[4 * q4] * inv, O0[4 * q4 + 1] * inv); w0.y = pk2(O0[4 * q4 + 2] * inv, O0[4 * q4 + 3] * inv);
            w1.x = pk2(O1[4 * q4] * inv, O1[4 * q4 + 1] * inv); w1.y = pk2(O1[4 * q4 + 2] * inv, O1[4 * q4 + 3] * inv);
            *(u32x2*)(yrow + 8 * q4 + 4 * hh) = w0; *(u32x2*)(yrow + 32 + 8 * q4 + 4 * hh) = w1;
        }
    }
}

__device__ __forceinline__ void dt_phase(const Frame& F, const Args& A) {
    const int lane = F.lane, wave = F.wave, tid = F.tid, fr = lane & 15, fq = lane >> 4;
    const bf16* XN = (const bf16*)(F.ws + WS_XN);
    const bf16* Wdt = (const bf16*)(F.ws + WS_WSIN) + (size_t)5120 * 1024;
    float* DT = (float*)(F.ws + WS_DT);
    LAS float* part = (LAS float*)F.lds;
    for (int blk = blockIdx.x; blk < T / 64; blk += F.G) {
        const int row0 = blk * 64;
        f32x4 acc[4][4];
#pragma unroll
        for (int m = 0; m < 4; ++m)
#pragma unroll
            for (int n = 0; n < 4; ++n) acc[m][n] = (f32x4){0.f, 0.f, 0.f, 0.f};
#pragma unroll
        for (int ks = 0; ks < 4; ++ks) {
            const int k0 = wave * 128 + ks * 32 + fq * 8;
            bf16x8 af[4], bfm[4];
#pragma unroll
            for (int m = 0; m < 4; ++m) af[m] = *(const bf16x8*)(XN + (size_t)(row0 + m * 16 + fr) * D + k0);
#pragma unroll
            for (int n = 0; n < 4; ++n) bfm[n] = *(const bf16x8*)(Wdt + (size_t)(n * 16 + fr) * D + k0);
#pragma unroll
            for (int m = 0; m < 4; ++m)
#pragma unroll
                for (int n = 0; n < 4; ++n) acc[m][n] = __builtin_amdgcn_mfma_f32_16x16x32_bf16(af[m], bfm[n], acc[m][n], 0, 0, 0);
        }
        __syncthreads();
#pragma unroll
        for (int m = 0; m < 4; ++m)
#pragma unroll
            for (int n = 0; n < 4; ++n)
#pragma unroll
                for (int i = 0; i < 4; ++i) part[wave * 4096 + (m * 16 + 4 * fq + i) * 64 + n * 16 + fr] = acc[m][n][i];
        __syncthreads();
        for (int i = tid; i < 4096; i += 512) {
            float v = 0.f;
#pragma unroll
            for (int w = 0; w < 8; ++w) v += part[w * 4096 + i];
            const int col = i & 63;
            v += (col < 32) ? A.in[I_ODTBF][col] : A.in[I_ODTBB][col - 32];
            const float sp = v > 20.f ? v : log1pf(__expf(v));
            DT[(size_t)(row0 + (i >> 6)) * 64 + col] = sp;
        }
    }
}

constexpr int RS = 136;
constexpr int SL_BN = 0, SL_CN = 34816, SL_XT = 69632, SL_SC = 139264;
constexpr int SQ_BT = 0, SQ_XT = 34816, SQ_ST = 52224, SQ_E = 69632, SQ_W = 70144;
constexpr int SC_REC = 1536;

__device__ __forceinline__ bf16x8 pack8(const f32x16& v, int s2) {
    u32x4 w; w.x = pk2(v[8 * s2 + 0], v[8 * s2 + 1]); w.y = pk2(v[8 * s2 + 2], v[8 * s2 + 3]); w.z = pk2(v[8 * s2 + 4], v[8 * s2 + 5]); w.w = pk2(v[8 * s2 + 6], v[8 * s2 + 7]);
    return __builtin_bit_cast(bf16x8, w);
}

__device__ __forceinline__ void ssd_local_unit(const Frame& F, const Args& A, int b, int c, int g, int hf) {
    const int tid = F.tid, lane = F.lane, wave = F.wave, l31 = lane & 31, hh = lane >> 5;
    LAS bf16* Bn = (LAS bf16*)(F.lds + SL_BN); LAS bf16* Cn = (LAS bf16*)(F.lds + SL_CN); LAS bf16* XTl = (LAS bf16*)(F.lds + SL_XT);
    LAS float* scl = (LAS float*)(F.lds + SL_SC);
    const bf16* XBC = (const bf16*)(F.ws + WS_XBC);
    bf16* XTg = (bf16*)(F.ws + WS_XT); bf16* BTg = (bf16*)(F.ws + WS_BT); bf16* CNg = (bf16*)(F.ws + WS_CN);
    unsigned char* SCg = F.ws + WS_SC;
    const float* DT = (const float*)(F.ws + WS_DT);
    bf16* YM = (bf16*)(F.ws + WS_YM);
    const int recg = (b * 16 + c) * 4 + g;
    __syncthreads();
    for (int it = tid; it < 1024; it += 512) {
        const int ch8 = it & 63, tg = it >> 6, l0 = tg * 8;
        const int kind = ch8 < 16 ? 1 : (ch8 < 32 ? 2 : 0);
        const int xi = ch8 - 32, hl = xi >> 3;
        const int cc = kind == 1 ? ch8 * 8 : (kind == 2 ? (ch8 - 16) * 8 : (xi & 7) * 8);
        const int h = g * 8 + hf * 4 + hl;
        const int col = kind == 0 ? h * 64 + cc : (kind == 1 ? 2048 + g * 128 + cc : 2560 + g * 128 + cc);
        u32x4 inr[12];
#pragma unroll
        for (int r = 0; r < 12; ++r) { const int pos = c * 128 + l0 + r - 2;
            inr[r] = (u32x4){0u, 0u, 0u, 0u};
            if (pos >= 0 && pos < SEQ) inr[r] = *(const u32x4*)(XBC + (size_t)(b * SEQ + pos) * CDIM + col); }
        float o[8][8];
#pragma unroll
        for (int e = 0; e < 8; ++e) {
            float wv[5];
#pragma unroll
            for (int i = 0; i < 5; ++i) wv[i] = A.in[I_OCONVW][i * CDIM + col + e];
            const float bv = A.in[I_OCONVB][col + e];
            float xin[12];
#pragma unroll
            for (int r = 0; r < 12; ++r) { const unsigned w = (e >> 1) == 0 ? inr[r].x : ((e >> 1) == 1 ? inr[r].y : ((e >> 1) == 2 ? inr[r].z : inr[r].w)); xin[r] = (e & 1) ? bfhi(w) : bflo(w); }
#pragma unroll
            for (int t = 0; t < 8; ++t) { float sacc = bv;
#pragma unroll
                for (int i = 0; i < 5; ++i) sacc += xin[t + i] * wv[i];
                o[t][e] = sacc / (1.0f + __expf(-sacc)); }
        }
        if (kind != 0) {
            LAS bf16* Nn = kind == 1 ? Bn : Cn;
#pragma unroll
            for (int t = 0; t < 8; ++t) { u32x4 w; w.x = pk2(o[t][0], o[t][1]); w.y = pk2(o[t][2], o[t][3]); w.z = pk2(o[t][4], o[t][5]); w.w = pk2(o[t][6], o[t][7]);
                *(LAS u32x4*)(Nn + (l0 + t) * RS + cc) = w;
                if (kind == 2 && hf == 0) *(u32x4*)(CNg + (size_t)recg * 16384 + (l0 + t) * 128 + cc) = w; }
        }
        if (kind != 2) {
#pragma unroll
            for (int e = 0; e < 8; ++e) { u32x4 w; w.x = pk2(o[0][e], o[1][e]); w.y = pk2(o[2][e], o[3][e]); w.z = pk2(o[4][e], o[5][e]); w.w = pk2(o[6][e], o[7][e]);
                if (kind == 0) { *(LAS u32x4*)(XTl + hl * (64 * RS) + (cc + e) * RS + l0) = w;
                    *(u32x4*)(XTg + ((size_t)((b * 16 + c) * 32 + h)) * 8192 + (cc + e) * 128 + l0) = w; }
                else if (hf == 0) *(u32x4*)(BTg + (size_t)recg * 16384 + (cc + e) * 128 + l0) = w; }
        }
    }
    {
        const int hl = wave >> 1, dir = wave & 1, h = g * 8 + hf * 4 + hl;
        LAS float* dtv = scl + hl * 512 + dir * 128;
        LAS float* cum = scl + hl * 512 + 256 + dir * 128;
        unsigned char* rec = SCg + (size_t)((b * 16 + c) * 32 + h) * SC_REC;
        const float Ah = -__expf(A.in[dir ? I_OALB : I_OALF][h]);
        const float d0 = DT[(size_t)(b * SEQ + c * 128 + 2 * lane) * 64 + dir * 32 + h], d1 = DT[(size_t)(b * SEQ + c * 128 + 2 * lane + 1) * 64 + dir * 32 + h];
        const float a0 = Ah * d0, a1 = Ah * d1; float s = a0 + a1;
#pragma unroll
        for (int o = 1; o < 64; o <<= 1) { const float t = __shfl_up(s, o); if (lane >= o) s += t; }
        const float tot = __shfl(s, 63);
        float c0, c1;
        if (dir == 0) { c1 = s; c0 = s - a1; } else { c0 = tot - s + a0 + a1; c1 = tot - s + a1; }
        dtv[2 * lane] = d0; dtv[2 * lane + 1] = d1; cum[2 * lane] = c0; cum[2 * lane + 1] = c1;
        float* Eg = (float*)(rec + dir * 512); unsigned* Wg = (unsigned*)(rec + 1024 + dir * 256);
        *(float2*)(Eg + 2 * lane) = make_float2(__expf(c0), __expf(c1));
        Wg[lane] = pk2(__expf(tot - c0) * d0, __expf(tot - c1) * d1);
    }
    __syncthreads();
    {
        const int hl = wave >> 1, h = g * 8 + hf * 4 + hl;
        LAS float* dtf = scl + hl * 512, *dtb = dtf + 128, *af = dtf + 256, *rbv = dtf + 384;
        LAS bf16* XT = XTl + hl * (64 * RS);
        const float Dh = A.in[I_OD][h];
#pragma unroll 1
        for (int li = 0; li < 2; ++li) {
            const int lt = 2 * (wave & 1) + li, l = 32 * lt + l31;
            const float myaf = af[l], myrb = rbv[l];
            f32x16 Y0, Y1;
#pragma unroll
            for (int r = 0; r < 16; ++r) { Y0[r] = 0.f; Y1[r] = 0.f; }
#pragma unroll 1
            for (int st = 0; st < 4; ++st) {
                f32x16 cb;
#pragma unroll
                for (int r = 0; r < 16; ++r) cb[r] = 0.f;
#pragma unroll
                for (int ks = 0; ks < 8; ++ks) { const bf16x8 cf = *(const LAS bf16x8*)(Cn + l * RS + 16 * ks + 8 * hh);
                    const bf16x8 bfr = *(const LAS bf16x8*)(Bn + (32 * st + l31) * RS + 16 * ks + 8 * hh);
                    cb = __builtin_amdgcn_mfma_f32_32x32x16_bf16(bfr, cf, cb, 0, 0, 0); }
#pragma unroll
                for (int r4 = 0; r4 < 4; ++r4) { const int s0 = 32 * st + 8 * r4 + 4 * hh;
                    const f32x4 afs = *(const LAS f32x4*)(af + s0), rbs = *(const LAS f32x4*)(rbv + s0), dfs = *(const LAS f32x4*)(dtf + s0), dbs = *(const LAS f32x4*)(dtb + s0);
#pragma unroll
                    for (int j = 0; j < 4; ++j) { const int s = s0 + j;
                        const float wgt = (s < l) ? __expf(myaf - afs[j]) * dfs[j] : ((s > l) ? __expf(myrb - rbs[j]) * dbs[j] : (dfs[j] + dbs[j]));
                        cb[4 * r4 + j] *= wgt; } }
#pragma unroll
                for (int s2 = 0; s2 < 2; ++s2) { const int kb = 32 * st + 16 * s2 + 4 * hh; const bf16x8 mf = pack8(cb, s2);
                    { const u32x2 lo = *(const LAS u32x2*)(XT + l31 * RS + kb), hi = *(const LAS u32x2*)(XT + l31 * RS + kb + 8); const u32x4 xw = (u32x4){lo.x, lo.y, hi.x, hi.y};
                      Y0 = __builtin_amdgcn_mfma_f32_32x32x16_bf16(__builtin_bit_cast(bf16x8, xw), mf, Y0, 0, 0, 0); }
                    { const u32x2 lo = *(const LAS u32x2*)(XT + (32 + l31) * RS + kb), hi = *(const LAS u32x2*)(XT + (32 + l31) * RS + kb + 8); const u32x4 xw = (u32x4){lo.x, lo.y, hi.x, hi.y};
                      Y1 = __builtin_amdgcn_mfma_f32_32x32x16_bf16(__builtin_bit_cast(bf16x8, xw), mf, Y1, 0, 0, 0); } }
            }
            bf16* yrow = YM + (size_t)(b * SEQ + c * 128 + l) * DI + h * 64;
#pragma unroll
            for (int q4 = 0; q4 < 4; ++q4) { const int p0 = 8 * q4 + 4 * hh;
                float x0[4], x1[4];
#pragma unroll
                for (int j = 0; j < 4; ++j) { x0[j] = bf1(XT[(p0 + j) * RS + l]); x1[j] = bf1(XT[(32 + p0 + j) * RS + l]); }
                u32x2 w0, w1;
                w0.x = pk2(Y0[4 * q4] + Dh * x0[0], Y0[4 * q4 + 1] + Dh * x0[1]); w0.y = pk2(Y0[4 * q4 + 2] + Dh * x0[2], Y0[4 * q4 + 3] + Dh * x0[3]);
                w1.x = pk2(Y1[4 * q4] + Dh * x1[0], Y1[4 * q4 + 1] + Dh * x1[1]); w1.y = pk2(Y1[4 * q4 + 2] + Dh * x1[2], Y1[4 * q4 + 3] + Dh * x1[3]);
                *(u32x2*)(yrow + p0) = w0; *(u32x2*)(yrow + 32 + p0) = w1; }
        }
    }
}

__device__ __forceinline__ void ssd_seq_unit(const Frame& F, const Args& A, int b, int h) {
    const int tid = F.tid, lane = F.lane, wave = F.wave, l31 = lane & 31, hh = lane >> 5;
    LAS bf16* BT = (LAS bf16*)(F.lds + SQ_BT); LAS bf16* XT = (LAS bf16*)(F.lds + SQ_XT); LAS bf16* St = (LAS bf16*)(F.lds + SQ_ST);
    LAS float* El = (LAS float*)(F.lds + SQ_E); LAS float* Wl = (LAS float*)(F.lds + SQ_W);
    const bf16* XTg = (const bf16*)(F.ws + WS_XT); const bf16* BTg = (const bf16*)(F.ws + WS_BT); const bf16* CNg = (const bf16*)(F.ws + WS_CN);
    const unsigned char* SCg = F.ws + WS_SC;
    bf16* YM = (bf16*)(F.ws + WS_YM);
    const int g = h >> 3;
    const int lt = wave & 3, pt = wave >> 2;
    const int pt2 = wave & 1, nt = wave >> 1;
    for (int dir = 0; dir < 2; ++dir) {
        u32x4 pb[4], px[2], pc[8]; u32x2 ymn[4]; float pe = 0.f; unsigned pw = 0u;
#define SSD_PREFETCH(cc) do { const size_t rg_ = (size_t)((b * 16 + (cc)) * 4 + g), rh_ = (size_t)((b * 16 + (cc)) * 32 + h); \
        _Pragma("unroll") for (int i_ = 0; i_ < 4; ++i_) pb[i_] = *(const u32x4*)(BTg + rg_ * 16384 + (size_t)(tid + 512 * i_) * 8); \
        _Pragma("unroll") for (int i_ = 0; i_ < 2; ++i_) px[i_] = *(const u32x4*)(XTg + rh_ * 8192 + (size_t)(tid + 512 * i_) * 8); \
        _Pragma("unroll") for (int k_ = 0; k_ < 8; ++k_) pc[k_] = *(const u32x4*)(CNg + rg_ * 16384 + (32 * lt + l31) * 128 + 16 * k_ + 8 * hh); \
        if (tid < 128) { const unsigned char* rec_ = SCg + rh_ * SC_REC; pe = *(const float*)(rec_ + dir * 512 + tid * 4); pw = (unsigned)*(const bf16*)(rec_ + 1024 + dir * 256 + tid * 2); } \
        { const bf16* yr_ = YM + (size_t)(b * SEQ + (cc) * 128 + 32 * lt + l31) * DI + h * 64 + 32 * pt; \
        _Pragma("unroll") for (int q_ = 0; q_ < 4; ++q_) ymn[q_] = *(const u32x2*)(yr_ + 8 * q_ + 4 * hh); } } while (0)
#define SSD_COMMIT() do { \
        _Pragma("unroll") for (int i_ = 0; i_ < 4; ++i_) { const int q_ = tid + 512 * i_; *(LAS u32x4*)(BT + (q_ >> 4) * RS + (q_ & 15) * 8) = pb[i_]; } \
        _Pragma("unroll") for (int i_ = 0; i_ < 2; ++i_) { const int q_ = tid + 512 * i_; *(LAS u32x4*)(XT + (q_ >> 4) * RS + (q_ & 15) * 8) = px[i_]; } \
        if (tid < 128) { El[tid] = pe; Wl[tid] = __uint_as_float(pw << 16); } } while (0)
        __syncthreads();
        SSD_PREFETCH(dir ? 15 : 0);
        for (int i = tid; i < 64 * RS / 2; i += 512) ((LAS unsigned*)St)[i] = 0u;
        SSD_COMMIT();
        f32x16 stacc;
#pragma unroll
        for (int r = 0; r < 16; ++r) stacc[r] = 0.f;
        for (int step = 0; step < 16; ++step) {
            const int c = dir ? 15 - step : step;
            u32x4 cc8[8]; u32x2 ym[4];
#pragma unroll
            for (int k = 0; k < 8; ++k) cc8[k] = pc[k];
#pragma unroll
            for (int q4 = 0; q4 < 4; ++q4) ym[q4] = ymn[q4];
            __syncthreads();
            if (step < 15) SSD_PREFETCH(dir ? 14 - step : step + 1);
            bf16* yrow = YM + (size_t)(b * SEQ + c * 128 + 32 * lt + l31) * DI + h * 64 + 32 * pt;
            f32x16 Yo;
#pragma unroll
            for (int r = 0; r < 16; ++r) Yo[r] = 0.f;
#pragma unroll
            for (int ks = 0; ks < 8; ++ks) { const bf16x8 sf = *(const LAS bf16x8*)(St + (32 * pt + l31) * RS + 16 * ks + 8 * hh);
                Yo = __builtin_amdgcn_mfma_f32_32x32x16_bf16(sf, __builtin_bit_cast(bf16x8, cc8[ks]), Yo, 0, 0, 0); }
            const float e_l = El[32 * lt + l31];
#pragma unroll
            for (int q4 = 0; q4 < 4; ++q4) { u32x2 w;
                w.x = pk2(bflo(ym[q4].x) + e_l * Yo[4 * q4], bfhi(ym[q4].x) + e_l * Yo[4 * q4 + 1]); w.y = pk2(bflo(ym[q4].y) + e_l * Yo[4 * q4 + 2], bfhi(ym[q4].y) + e_l * Yo[4 * q4 + 3]);
                *(u32x2*)(yrow + 8 * q4 + 4 * hh) = w; }
            const float decay = dir ? El[0] : El[127];
#pragma unroll
            for (int r = 0; r < 16; ++r) stacc[r] *= decay;
            const int pp = 32 * pt2 + l31, nn = 32 * nt + l31;
#pragma unroll
            for (int ks = 0; ks < 8; ++ks) { const int l0 = 16 * ks + 8 * hh;
                const u32x4 xr = *(const LAS u32x4*)(XT + pp * RS + l0); const f32x4 w0 = *(const LAS f32x4*)(Wl + l0), w1 = *(const LAS f32x4*)(Wl + l0 + 4);
                u32x4 xs; xs.x = pk2(bflo(xr.x) * w0[0], bfhi(xr.x) * w0[1]); xs.y = pk2(bflo(xr.y) * w0[2], bfhi(xr.y) * w0[3]);
                xs.z = pk2(bflo(xr.z) * w1[0], bfhi(xr.z) * w1[1]); xs.w = pk2(bflo(xr.w) * w1[2], bfhi(xr.w) * w1[3]);
                const bf16x8 bt = *(const LAS bf16x8*)(BT + nn * RS + l0);
                stacc = __builtin_amdgcn_mfma_f32_32x32x16_bf16(__builtin_bit_cast(bf16x8, xs), bt, stacc, 0, 0, 0); }
            __syncthreads();
            if (step < 15) {
                SSD_COMMIT();
#pragma unroll
                for (int r = 0; r < 16; ++r) { const int prow = 32 * pt2 + (r & 3) + 8 * (r >> 2) + 4 * hh; St[prow * RS + nn] = (bf16)(pk2(stacc[r], 0.f) & 0xffffu); }
            }
        }
#undef SSD_PREFETCH
#undef SSD_COMMIT
    }
}

__device__ __forceinline__ void gnorm_phase(const Frame& F, const Args& A) {
    const int lane = F.lane;
    const bf16* YM = (const bf16*)(F.ws + WS_YM); const bf16* Z = (const bf16*)(F.ws + WS_Z); bf16* YN = (bf16*)(F.ws + WS_YN);
    const float* gw = A.in[I_OGN];
    const int gwv = F.vcu * 8 + F.wave, NGW = F.G * 8;
    for (int row = gwv; row < T; row += NGW) {
        float v[32]; float ss = 0.f;
#pragma unroll
        for (int j = 0; j < 4; ++j) { const int c = 8 * lane + 512 * j;
            const u32x4 y4 = *(const u32x4*)(YM + (size_t)row * DI + c), z4 = *(const u32x4*)(Z + (size_t)row * DI + c);
            const unsigned yw[4] = {y4.x, y4.y, y4.z, y4.w}, zw[4] = {z4.x, z4.y, z4.z, z4.w};
#pragma unroll
            for (int e = 0; e < 4; ++e) { const float a = bflo(yw[e]) * siluf(bflo(zw[e])), c2 = bfhi(yw[e]) * siluf(bfhi(zw[e])); v[j * 8 + 2 * e] = a; v[j * 8 + 2 * e + 1] = c2; ss += a * a + c2 * c2; } }
        const float rstd = 1.0f / sqrtf(wave_sum(ss) * (1.0f / DI) + EPS);
#pragma unroll
        for (int j = 0; j < 4; ++j) { const int c = 8 * lane + 512 * j; const f32x4 g0 = *(const f32x4*)(gw + c), g1 = *(const f32x4*)(gw + c + 4);
            u32x4 o; o.x = pk2(v[j * 8] * rstd * g0[0], v[j * 8 + 1] * rstd * g0[1]); o.y = pk2(v[j * 8 + 2] * rstd * g0[2], v[j * 8 + 3] * rstd * g0[3]);
            o.z = pk2(v[j * 8 + 4] * rstd * g1[0], v[j * 8 + 5] * rstd * g1[1]); o.w = pk2(v[j * 8 + 6] * rstd * g1[2], v[j * 8 + 7] * rstd * g1[3]);
            *(u32x4*)(YN + (size_t)row * DI + c) = o; }
    }
}

__device__ __forceinline__ int moe_tables(const Frame& F, LAS int* pexp  , LAS int* eoff  , LAS int* ecnt  ) {
    const unsigned* gcnt = (const unsigned*)(F.ws + WS_CTL) + CW_GCNT;
    __syncthreads();
    if (F.tid == 0) { int off = 0; for (int e = 0; e < 8; ++e) { const int cnt = (int)__hip_atomic_load(gcnt + e, __ATOMIC_RELAXED, __HIP_MEMORY_SCOPE_AGENT); ecnt[e] = cnt; eoff[e] = off; const int np = (cnt + 255) >> 8;
            for (int p = 0; p < np; ++p) pexp[(off >> 8) + p] = e; off += np << 8; } eoff[8] = off; }
    __syncthreads();
    return eoff[8] >> 8;
}
__device__ __forceinline__ void gather_phase(const Frame& F) {
    LAS int* pexp = (LAS int*)F.lds; LAS int* eoff = pexp + MAXPAN; LAS int* ecnt = eoff + 9;
    const int npan = moe_tables(F, pexp, eoff, ecnt);
    const int* toke = (const int*)(F.ws + WS_ROUTE + RT_TOKE); const int* tokp = (const int*)(F.ws + WS_ROUTE + RT_TOKP); int* rowtok = (int*)(F.ws + WS_ROUTE + RT_ROWTOK);
    const bf16* XN = (const bf16*)(F.ws + WS_XN); bf16* AP = (bf16*)(F.ws + WS_AP);
    const int gwv = F.vcu * 8 + F.wave, NGW = F.G * 8, lane = F.lane;
    for (int i = gwv; i < T * 2; i += NGW) {
        const int e = toke[i], row = eoff[e] + tokp[i], tok = i >> 1;
        if (lane == 0) rowtok[row] = i;
        const u32x4* src = (const u32x4*)(XN + (size_t)tok * D); u32x4* dst = (u32x4*)(AP + (size_t)row * D);
        dst[lane] = src[lane]; dst[lane + 64] = src[lane + 64];
    }
    const int npad_total = npan * 256;
    for (int row = gwv; row < npad_total; row += NGW) {
        const int e = pexp[row >> 8];
        if (row >= eoff[e] + ecnt[e]) { if (lane == 0) rowtok[row] = -1;
            u32x4* dst = (u32x4*)(AP + (size_t)row * D); dst[lane] = (u32x4){0u, 0u, 0u, 0u}; dst[lane + 64] = (u32x4){0u, 0u, 0u, 0u}; }
    }
}

__device__ __forceinline__ void combine_phase(const Frame& F, const Args& A, float* out) {
    const int lane = F.lane;
    const bf16* YS = (const bf16*)(F.ws + WS_YS); const float* tokw = (const float*)(F.ws + WS_ROUTE + RT_TOKW);
    const float* g2 = (const float*)(F.ws + WS_MOD) + 49152 + 5120;
    const int gwv = F.vcu * 8 + F.wave, NGW = F.G * 8;
    for (int tok = gwv; tok < T; tok += NGW) {
        const float w0 = tokw[2 * tok], w1 = tokw[2 * tok + 1]; const int b = tok / SEQ;
        const bf16* y0 = YS + (size_t)(2 * tok) * D, *y1 = y0 + D; float* orow = out + (size_t)tok * D; const float* gr = g2 + b * 6144;
#pragma unroll
        for (int j = 0; j < 2; ++j) { const int c = 8 * lane + 512 * j;
            const u32x4 a4 = *(const u32x4*)(y0 + c), b4 = *(const u32x4*)(y1 + c);
            const f32x4 g0 = *(const f32x4*)(gr + c), g1 = *(const f32x4*)(gr + c + 4); f32x4 o0 = *(const f32x4*)(orow + c), o1 = *(const f32x4*)(orow + c + 4);
            o0[0] += g0[0] * (w0 * bflo(a4.x) + w1 * bflo(b4.x)); o0[1] += g0[1] * (w0 * bfhi(a4.x) + w1 * bfhi(b4.x));
            o0[2] += g0[2] * (w0 * bflo(a4.y) + w1 * bflo(b4.y)); o0[3] += g0[3] * (w0 * bfhi(a4.y) + w1 * bfhi(b4.y));
            o1[0] += g1[0] * (w0 * bflo(a4.z) + w1 * bflo(b4.z)); o1[1] += g1[1] * (w0 * bfhi(a4.z) + w1 * bfhi(b4.z));
            o1[2] += g1[2] * (w0 * bflo(a4.w) + w1 * bflo(b4.w)); o1[3] += g1[3] * (w0 * bfhi(a4.w) + w1 * bfhi(b4.w));
            *(f32x4*)(orow + c) = o0; *(f32x4*)(orow + c + 4) = o1; }
    }
}

constexpr int NPHASE = 19;
__global__ void __launch_bounds__(512, 2) hybrid_fwd(Args args) {
    extern __shared__ __attribute__((aligned(16))) unsigned char lds_raw[];
    Frame F0;
    F0.lds = (LAS unsigned char*)lds_raw; F0.ws = args.ws;
    F0.tid = threadIdx.x; F0.lane = F0.tid & 63; F0.wave = __builtin_amdgcn_readfirstlane(F0.tid >> 6);
    F0.G = gridDim.x; { const int bx = blockIdx.x; F0.vcu = (F0.G % 8 == 0) ? (bx % 8) * (F0.G / 8) + bx / 8 : bx; }
    volatile LAS unsigned* MISC = (volatile LAS unsigned*)(F0.lds + MISC_OFF);
    if (F0.tid < 32) MISC[F0.tid] = 0u;
    __syncthreads();
    unsigned* ctl = (unsigned*)(args.ws + WS_CTL);
    XcdBarrier bar; bar.bar = ctl + CW_BAR; bar.x = 0; bar.st = nullptr;
#if MK_N_LAUNCHES == 1
    bar = xcd_barrier_post(ctl + CW_BAR, MISC + 8);
#define GRID_BAR() xcd_barrier(bar)
#else
#define GRID_BAR() do { } while (0)
#endif
    const int lo = args.ph_lo, hi = args.ph_hi;
#ifndef PHASE_MASK
#define PHASE_MASK 0x7ffff
#endif
#define IN(k) ((((PHASE_MASK) >> (k)) & 1) && lo <= (k) && (k) < hi)
#define SEAM(k) do { if (IN(k) && IN((k) + 1)) GRID_BAR(); } while (0)
#ifndef REP_PHASE
#define REP_PHASE -1
#endif
#define PHASE_BODY(...) { unsigned char* ws = args.ws; asm volatile("" : "+s"(ws)); Frame F = F0; F.ws = ws; const float* MOD = (const float*)(ws + WS_MOD); (void)MOD; __VA_ARGS__ }
#define PHASE(k, ...) do { if (IN(k)) PHASE_BODY(__VA_ARGS__) if ((REP_PHASE) == (k) && IN(k)) { __syncthreads(); PHASE_BODY(__VA_ARGS__) } } while (0)
    const int c = (int)blockIdx.x;

    PHASE(0,  p0_prologue(F, args); ); SEAM(0);
    PHASE(1,  modulate_phase<0>(F, args, args.in[I_X], args.in[I_EN1], 0, 0); ); SEAM(1);
    PHASE(2,
        { SchedPlain S{(const char*)(ws + WS_WU), (const char*)(ws + WS_XN), 4, 64, F.G, c, (size_t)256 * 1024 * 2}; EpiUT E{(bf16*)(ws + WS_UT)};
          pg8::gemm_phase(F.lds, 1024, S, E); }
        { SchedPlain S{(const char*)(ws + WS_XN), (const char*)(ws + WS_WQKV), 64, 3, F.G, c, (size_t)256 * 1024 * 2}; EpiBf16 E{(bf16*)(ws + WS_QKV), QKVW};
          pg8::gemm_phase(F.lds, 1024, S, E); }
    ); SEAM(2);
    PHASE(3,
        const int sub = F.vcu & 31, x = F.vcu >> 5;
        if (sub < 16) { SchedFourier S{(const char*)(ws + WS_FDFT), (const char*)(ws + WS_UT), x * 16 + sub}; EpiBf16 E{(bf16*)(ws + WS_Y0), D};
            pg8::gemm_phase(F.lds, 4096, S, E); }
        else { const int a = sub - 16; attn_unit(F, args, x, a, 0); attn_unit(F, args, x, a, 1); }
    ); SEAM(3);
    PHASE(4,  SchedPlain S{(const char*)(ws + WS_Y0), (const char*)(ws + WS_WO0), 64, 4, F.G, c, (size_t)256 * 1024 * 2}; EpiRes E{args.in[I_X], args.out, MOD + 2048};
        pg8::gemm_phase(F.lds, 1024, S, E); ); SEAM(4);
    PHASE(5,  modulate_phase<1>(F, args, args.out, args.in[I_EN2], 0, 1); ); SEAM(5);
    PHASE(6,  SchedPlain S{(const char*)(ws + WS_XN), (const char*)(ws + WS_WF13), 64, 22, F.G, c, (size_t)256 * 1024 * 2}; EpiSwiglu E{(bf16*)(ws + WS_H0), DFF};
        pg8::gemm_phase(F.lds, 1024, S, E); ); SEAM(6);
    PHASE(7,  SchedPlain S{(const char*)(ws + WS_H0), (const char*)(ws + WS_WF2), 64, 4, F.G, c, (size_t)256 * DFF * 2}; EpiRes E{args.out, args.out, MOD + 5120};
        pg8::gemm_phase(F.lds, DFF, S, E); ); SEAM(7);
    PHASE(8,  modulate_phase<1>(F, args, args.out, args.in[I_ON1], 1, 0); ); SEAM(8);
    PHASE(9,  { SchedPlain S{(const char*)(ws + WS_XN), (const char*)(ws + WS_WSIN), 64, 20, F.G, c, (size_t)256 * 1024 * 2}; EpiSsmIn E{(bf16*)(ws + WS_Z), (bf16*)(ws + WS_XBC)};
        pg8::gemm_phase(F.lds, 1024, S, E); } dt_phase(F, args); ); SEAM(9);
    PHASE(10,  for (int u = F.vcu; u < 1024; u += F.G) ssd_local_unit(F, args, u >> 7, (u >> 3) & 15, (u >> 1) & 3, u & 1); ); SEAM(10);
    PHASE(11,  for (int u = F.vcu; u < NBATCH * NHEAD_SSM; u += F.G) ssd_seq_unit(F, args, u >> 5, u & 31); ); SEAM(11);
    PHASE(12,  gnorm_phase(F, args); ); SEAM(12);
    PHASE(13,  SchedPlain S{(const char*)(ws + WS_YN), (const char*)(ws + WS_WSOUT), 64, 4, F.G, c, (size_t)256 * DI * 2}; EpiRes E{args.out, args.out, MOD + 49152 + 2048};
        pg8::gemm_phase(F.lds, DI, S, E); ); SEAM(13);
    PHASE(14,  modulate_phase<2>(F, args, args.out, args.in[I_ON2], 1, 1); ); SEAM(14);
    PHASE(15,  gather_phase(F); ); SEAM(15);
    PHASE(16,  LAS int* pexp = (LAS int*)(F.lds + 131072 + 4096); LAS int* eoff = pexp + MAXPAN; LAS int* ecnt = eoff + 9;
        const int npan = moe_tables(F, pexp, eoff, ecnt);
        SchedMoe S{(const char*)(ws + WS_AP), (const char*)(ws + WS_WM13), pexp, npan, 28, F.G, c, (size_t)256 * 1024 * 2, (size_t)256 * 1024 * 2, 28}; EpiSwiglu E{(bf16*)(ws + WS_HP), DFE};
        pg8::gemm_phase(F.lds, 1024, S, E); ); SEAM(16);
    PHASE(17,  LAS int* pexp = (LAS int*)(F.lds + 131072 + 4096); LAS int* eoff = pexp + MAXPAN; LAS int* ecnt = eoff + 9;
        const int npan = moe_tables(F, pexp, eoff, ecnt);
        SchedMoe S{(const char*)(ws + WS_HP), (const char*)(ws + WS_WM2), pexp, npan, 4, F.G, c, (size_t)256 * DFE * 2, (size_t)256 * DFE * 2, 4};
        EpiMoeSlot E{(bf16*)(ws + WS_YS), (const int*)(ws + WS_ROUTE + RT_ROWTOK)};
        pg8::gemm_phase(F.lds, DFE, S, E); ); SEAM(17);
    PHASE(18,  combine_phase(F, args, args.out); );
#undef IN
#undef SEAM
}

extern "C" void kernel_launch(void* const* d_in, const int* in_sizes, int n_in, void* d_out, int out_size, void* d_ws, size_t ws_size, hipStream_t stream) {
    static int grid = 0;
    if (grid == 0) {
        if (n_in != 34 || ws_size < WS_END) { grid = -1; return; }
        int dev = 0, cus = 0;
        if (hipGetDevice(&dev) != hipSuccess || hipDeviceGetAttribute(&cus, hipDeviceAttributeMultiprocessorCount, dev) != hipSuccess) { grid = -1; return; }
        if (hipFuncSetAttribute((const void*)hybrid_fwd, hipFuncAttributeMaxDynamicSharedMemorySize, LDS_BYTES) != hipSuccess) { grid = -1; return; }
        int per_cu = 0;
        (void)hipOccupancyMaxActiveBlocksPerMultiprocessor(&per_cu, (const void*)hybrid_fwd, 512, LDS_BYTES);
        (void)hipGetLastError();
        grid = cus;
    }
    if (grid < 0) return;
    (void)hipMemsetAsync((char*)d_ws + WS_CTL, 0, CTL_ZERO_BYTES, stream);
    Args a{};
    for (int i = 0; i < 34; ++i) a.in[i] = (const float*)d_in[i];
    a.out = (float*)d_out; a.ws = (unsigned char*)d_ws;
#if MK_N_LAUNCHES == 1
    a.ph_lo = 0; a.ph_hi = NPHASE;
    hipLaunchKernelGGL(hybrid_fwd, dim3(grid), dim3(512), LDS_BYTES, stream, a);
#else
    for (int p = 0; p < NPHASE; ++p) { a.ph_lo = p; a.ph_hi = p + 1; hipLaunchKernelGGL(hybrid_fwd, dim3(grid), dim3(512), LDS_BYTES, stream, a); }
#endif
}
```

```cpp
#include <hip/hip_runtime.h>
#include <stdint.h>

#ifndef MK_N_LAUNCHES
#define MK_N_LAUNCHES 1
#endif

#define LAS __attribute__((address_space(3)))
#define GAS __attribute__((address_space(1)))
typedef unsigned short bf16;
typedef short bf16x8 __attribute__((ext_vector_type(8)));
typedef float f32x4 __attribute__((ext_vector_type(4)));
typedef float f32x16 __attribute__((ext_vector_type(16)));
typedef unsigned u32x4 __attribute__((ext_vector_type(4)));
typedef unsigned u32x2 __attribute__((ext_vector_type(2)));

constexpr int D = 1024, NBATCH = 8, SEQ = 2048, T = NBATCH * SEQ;
constexpr int DFF = 2816, DI = 2048, CDIM = 3072, NHEAD_SSM = 32, NEXP = 8, DFE = 3584;
constexpr int QKVW = 768;
constexpr int MAXPAN = 136;
constexpr float EPS = 1e-6f;

constexpr size_t MiB = 1u << 20;
constexpr size_t WS_CTL = 0, CTL_ZERO_BYTES = 1 * MiB;
constexpr size_t WS_MODP = 1 * MiB;
constexpr size_t WS_MOD = 7 * MiB;
constexpr size_t WS_ROUTE = 7 * MiB + 512 * 1024;
constexpr size_t WS_WM13 = 9 * MiB;
constexpr size_t WS_WM2 = 121 * MiB;
constexpr size_t WS_WU = 192 * MiB;
constexpr size_t WS_WQKV = 194 * MiB;
constexpr size_t WS_WO0 = 196 * MiB;
constexpr size_t WS_WF13 = 198 * MiB;
constexpr size_t WS_WF2 = 209 * MiB;
constexpr size_t WS_WSIN = 181 * MiB;
constexpr size_t WS_WSOUT = 177 * MiB;
constexpr size_t WS_FDFT = 215 * MiB;
constexpr size_t WS_ACT = 231 * MiB;
constexpr size_t WS_XN = WS_ACT;
constexpr size_t WS_UT = WS_ACT + 32 * MiB;
constexpr size_t WS_QKV = WS_ACT + 64 * MiB;
constexpr size_t WS_Y0 = WS_ACT + 88 * MiB;
constexpr size_t WS_H0 = WS_ACT + 120 * MiB;
constexpr size_t WS_Z = WS_ACT + 32 * MiB;
constexpr size_t WS_XBC = WS_ACT + 96 * MiB;
constexpr size_t WS_DT = WS_ACT + 192 * MiB;
constexpr size_t WS_YM = WS_ACT + 196 * MiB;
constexpr size_t WS_YN = WS_XBC;
constexpr size_t WS_HP = 177 * MiB;
constexpr size_t WS_AP = 415 * MiB;
constexpr size_t WS_XT = 181 * MiB;
constexpr size_t WS_BT = 245 * MiB;
constexpr size_t WS_CN = WS_ACT + 260 * MiB;
constexpr size_t WS_SC = 1 * MiB;
constexpr size_t WS_YS = WS_WM13;
constexpr size_t WS_END = 507 * MiB;
constexpr size_t RT_TOKE = 0;
constexpr size_t RT_TOKP = 131072;
constexpr size_t RT_TOKW = 262144;
constexpr size_t RT_ROWTOK = 393216;
constexpr size_t RT_ROWW = 393216 + 139264;
constexpr int CW_BAR = 4096;
constexpr int CW_GCNT = 16384;

constexpr int LDS_BYTES = 163840 - 512;
constexpr int MISC_OFF = 160000;

__device__ __forceinline__ unsigned pk2(float lo, float hi) { unsigned r; asm volatile("v_cvt_pk_bf16_f32 %0, %1, %2" : "=v"(r) : "v"(lo), "v"(hi)); return r; }
__device__ __forceinline__ float bflo(unsigned u) { return __uint_as_float(u << 16); }
__device__ __forceinline__ float bfhi(unsigned u) { return __uint_as_float(u & 0xffff0000u); }
__device__ __forceinline__ float bf1(bf16 b) { return __uint_as_float(((unsigned)b) << 16); }
__device__ __forceinline__ float siluf(float x) { return x / (1.0f + __expf(-x)); }
__device__ __forceinline__ float wave_sum(float v) {
#pragma unroll
    for (int o = 1; o < 64; o <<= 1) v += __shfl_xor(v, o);
    return v;
}
__device__ __forceinline__ unsigned pk4_fp8(float a, float b, float c, float d) { int w = 0; w = __builtin_amdgcn_cvt_pk_fp8_f32(a, b, w, false); w = __builtin_amdgcn_cvt_pk_fp8_f32(c, d, w, true); return (unsigned)w; }
#define LDS_WAIT() asm volatile("s_waitcnt lgkmcnt(0)" ::: "memory")
#define VM_WAIT() asm volatile("s_waitcnt vmcnt(0)" ::: "memory")

namespace pg8 {
typedef int v4i_t __attribute__((ext_vector_type(4)));
typedef int v8i_t __attribute__((ext_vector_type(8)));
constexpr int BM = 256, BK = 64, HALF = 128, HTB = HALF * BK * 2, STAGE_BYTES = 8 * HTB, NXCD = 8, WGM = 8;
__host__ __device__ __forceinline__ int lds_byte(int r, int c) { const int st = (r >> 4) * 2 + (c >> 5), rr = r & 15, cc = c & 31, ob = rr * 64 + cc * 2; return st * 1024 + (ob ^ (((ob >> 9) & 1) << 5)); }
__host__ __device__ __forceinline__ void stage_rc(int b, int& R, int& C) { const int st = b / 1024, sb = b % 1024, swz = sb ^ (((sb >> 9) & 1) << 5); R = (st >> 1) * 16 + swz / 64; C = (st & 1) * 32 + (swz % 64) / 2; }
__host__ __device__ __forceinline__ int perm32(int rho) { const int n = rho >> 4, i = rho & 15; return 8 * (i >> 2) + 4 * n + (i & 3); }

struct Unit { const char* a; const char* b; int pm, pn; };

__device__ __forceinline__ bool tile_order(int i, int G, int c, int nM, int nN, int& pm, int& pn) {
    const int nwg = nM * nN; const long L = (long)i * G + c; if (L >= nwg) return false;
    int wgid = (int)L; { const int q = nwg / NXCD, r = nwg % NXCD, xcd = wgid % NXCD, off = wgid / NXCD; wgid = (xcd < r ? xcd * (q + 1) : r * (q + 1) + (xcd - r) * q) + off; }
    const int nig = WGM * nN, gid = wgid / nig, fm = gid * WGM, gsz = (nM - fm) < WGM ? (nM - fm) : WGM;
    pm = fm + ((wgid % nig) % gsz); pn = (wgid % nig) / gsz; return true;
}

template <class Epi, class Sched>
__device__ __forceinline__ void gemm_phase(LAS unsigned char* lds, const int RB, const Sched& S, const Epi& E) {
    const int tid = threadIdx.x, wid = __builtin_amdgcn_readfirstlane(tid >> 6), lane = tid & 63, wr = wid >> 2, wc = wid & 3, fr = lane & 15, fq = lane >> 4;
    const int nt = RB / 128;
    unsigned voffA[2], voffB[2];
#pragma unroll
    for (int i = 0; i < 2; ++i) { int R, C; stage_rc(tid * 16 + i * 8192, R, C); const int Rb = Epi::PERM ? ((R & ~31) + perm32(R & 31)) : R;
        voffA[i] = (unsigned)(R * RB + C * 2); voffB[i] = (unsigned)(Rb * RB + C * 2); }
    const size_t kstep = (size_t)(BK * 2);
    const size_t hstep = (size_t)HALF * RB;
    const unsigned ldsw = (unsigned)wid * 1024u;
    const int aoff = lds_byte(wr * 64 + fr, fq * 8), boff = lds_byte(wc * 32 + fr, fq * 8);
#define PG8_SA(b, h) (((b) * 2 + (h)) * HTB)
#define PG8_SB(b, h) ((4 + (b) * 2 + (h)) * HTB)
#define PG8_STAGE(bufoff, gbase, voff) do { _Pragma("unroll") for (int _i = 0; _i < 2; ++_i) \
        __builtin_amdgcn_global_load_lds((const unsigned*)((const char*)(gbase) + (voff)[_i]), (LAS unsigned*)(lds + (bufoff) + ldsw + _i * 8192), 16, 0, 0); } while (0)
#define PG8_LD8(addr) __builtin_shufflevector(*(const LAS v4i_t*)(addr), *(const LAS v4i_t*)((addr) + 1024), 0, 1, 2, 3, 4, 5, 6, 7)
#define PG8_LDA(dst, b, h) do { if constexpr (Epi::FP8) { _Pragma("unroll") for (int m = 0; m < 4; ++m) dst##8[m] = PG8_LD8(lds + PG8_SA(b, h) + aoff + m * 2048); } \
        else { _Pragma("unroll") for (int m = 0; m < 4; ++m) _Pragma("unroll") for (int k = 0; k < 2; ++k) dst[m][k] = *(const LAS bf16x8*)(lds + PG8_SA(b, h) + aoff + m * 2048 + k * 1024); } } while (0)
#define PG8_LDB(dst, b, h) do { if constexpr (Epi::FP8) { _Pragma("unroll") for (int n = 0; n < 2; ++n) dst##8[n] = PG8_LD8(lds + PG8_SB(b, h) + boff + n * 2048); } \
        else { _Pragma("unroll") for (int n = 0; n < 2; ++n) _Pragma("unroll") for (int k = 0; k < 2; ++k) dst[n][k] = *(const LAS bf16x8*)(lds + PG8_SB(b, h) + boff + n * 2048 + k * 1024); } } while (0)
#define PG8_MMA(ai, bj, At, Bt) do { __builtin_amdgcn_s_setprio(1); if constexpr (Epi::FP8) { _Pragma("unroll") for (int m = 0; m < 4; ++m) _Pragma("unroll") for (int n = 0; n < 2; ++n) \
            asm volatile("v_mfma_scale_f32_16x16x128_f8f6f4 %0, %1, %2, %0, %3, %3 op_sel_hi:[0,0,0]" : "+v"(acc[ai][bj][m][n]) : "v"(Bt##8[n]), "v"(At##8[m]), "v"(scl8)); } \
        else { _Pragma("unroll") for (int m = 0; m < 4; ++m) _Pragma("unroll") for (int n = 0; n < 2; ++n) _Pragma("unroll") for (int k = 0; k < 2; ++k) \
        acc[ai][bj][m][n] = __builtin_amdgcn_mfma_f32_16x16x32_bf16(Bt[n][k], At[m][k], acc[ai][bj][m][n], 0, 0, 0); } __builtin_amdgcn_s_setprio(0); } while (0)
#define PG8_WAIT_V(n) asm volatile("s_waitcnt vmcnt(" #n ")" ::: "memory")
#define PG8_WAIT_L(n) asm volatile("s_waitcnt lgkmcnt(" #n ")" ::: "memory")
#define PG8_BAR __builtin_amdgcn_s_barrier()
#define PG8_SCHED __builtin_amdgcn_sched_barrier(0)
    Unit cur, nxt; int ui = 0;
    if (!S.next(0, cur)) return;
    f32x4 acc[2][2][4][2];
#pragma unroll
    for (int a = 0; a < 2; ++a)
#pragma unroll
        for (int b = 0; b < 2; ++b)
#pragma unroll
            for (int m = 0; m < 4; ++m)
#pragma unroll
                for (int n = 0; n < 2; ++n) acc[a][b][m][n] = (f32x4){0.f, 0.f, 0.f, 0.f};
    bf16x8 At[4][2], B0[2][2], B1[2][2]; v8i_t At8[4], B08[2], B18[2]; const int scl8 = 0x7f7f7f7f;
    const char* cA = cur.a; const char* cB = cur.b;
    PG8_STAGE(PG8_SB(0, 0), cB, voffB); PG8_STAGE(PG8_SB(0, 1), cB + hstep, voffB); PG8_STAGE(PG8_SA(0, 0), cA, voffA); PG8_STAGE(PG8_SA(0, 1), cA + hstep, voffA);
    if (wr == 1) PG8_BAR;
    PG8_WAIT_V(2); PG8_BAR;
    PG8_STAGE(PG8_SB(1, 0), cB + kstep, voffB); PG8_STAGE(PG8_SA(1, 0), cA + kstep, voffA); PG8_STAGE(PG8_SB(1, 1), cB + hstep + kstep, voffB);
    PG8_WAIT_V(6); PG8_BAR;
    for (;;) {
        const bool has_next = S.next(ui + 1, nxt);
        const char* nA = has_next ? nxt.a : cA; const char* nB = has_next ? nxt.b : cB;
#pragma unroll 1
        for (int t = 0; t < nt; t += 2) {
            const bool last = (t == nt - 2);
            const char* a1 = cA + (size_t)(t + 1) * kstep;
            const char* a2 = last ? nA : cA + (size_t)(t + 2) * kstep; const char* b2 = last ? nB : cB + (size_t)(t + 2) * kstep;
            const char* a3 = a2 + kstep; const char* b3 = b2 + kstep;
            PG8_LDB(B0, 0, 0); PG8_LDB(B1, 0, 1); PG8_SCHED; PG8_LDA(At, 0, 0); PG8_STAGE(PG8_SA(1, 1), a1 + hstep, voffA);
            PG8_WAIT_V(8); PG8_WAIT_L(0); PG8_BAR; PG8_MMA(0, 0, At, B0); PG8_MMA(0, 1, At, B1); PG8_BAR; PG8_SCHED;
            PG8_LDA(At, 0, 1); PG8_STAGE(PG8_SB(0, 0), b2, voffB); PG8_STAGE(PG8_SB(0, 1), b2 + hstep, voffB); PG8_STAGE(PG8_SA(0, 0), a2, voffA);
            PG8_WAIT_V(8); PG8_WAIT_L(0); PG8_BAR; PG8_MMA(1, 0, At, B0); PG8_MMA(1, 1, At, B1); PG8_BAR; PG8_SCHED;
            PG8_LDB(B0, 1, 0); PG8_LDB(B1, 1, 1); PG8_SCHED; PG8_LDA(At, 1, 0); PG8_STAGE(PG8_SA(0, 1), a2 + hstep, voffA);
            PG8_WAIT_V(8); PG8_WAIT_L(0); PG8_BAR; PG8_MMA(0, 0, At, B0); PG8_MMA(0, 1, At, B1); PG8_BAR; PG8_SCHED;
            PG8_LDA(At, 1, 1); PG8_STAGE(PG8_SB(1, 0), b3, voffB); PG8_STAGE(PG8_SB(1, 1), b3 + hstep, voffB); PG8_STAGE(PG8_SA(1, 0), a3, voffA);
            PG8_WAIT_V(8); PG8_WAIT_L(0); PG8_BAR; PG8_MMA(1, 0, At, B0); PG8_MMA(1, 1, At, B1); PG8_BAR; PG8_SCHED;
        }
        if (wr == 0) PG8_BAR;
        if constexpr (Epi::FP8) asm volatile("s_nop 15\n\ts_nop 15\n\ts_nop 15\n\ts_nop 15\n\ts_nop 15" ::: "memory");
        E(acc, cur, wr, wc, fr, fq);
        if (!has_next) break;
#pragma unroll
        for (int a = 0; a < 2; ++a)
#pragma unroll
            for (int b = 0; b < 2; ++b)
#pragma unroll
                for (int m = 0; m < 4; ++m)
#pragma unroll
                    for (int n = 0; n < 2; ++n) acc[a][b][m][n] = (f32x4){0.f, 0.f, 0.f, 0.f};
        cur = nxt; cA = nA; cB = nB; ++ui;
        if (wr == 1) PG8_BAR;
    }
    PG8_WAIT_V(0);
    PG8_BAR;
#undef PG8_SA
#undef PG8_SB
#undef PG8_STAGE
#undef PG8_LDA
#undef PG8_LDB
#undef PG8_MMA
#undef PG8_WAIT_V
#undef PG8_WAIT_L
#undef PG8_BAR
#undef PG8_SCHED
}
}
using pg8::Unit;

#define XB_TMO      128
#define XB_XCNT(j)  (256  + 64 * (j))
#define XB_XSUB(j)  (1280 + 64 * (j))
#define XB_XGEN(j)  (2304 + 64 * (j))
#define XB_TOP      3328
#define XB_TOPGEN   3392
#define XCD_BAR_WORDS 3456
#define XB_SPIN_CAP (1u << 18)
__device__ __forceinline__ unsigned xb_ld(unsigned* p)              { return __hip_atomic_load(p, __ATOMIC_RELAXED, __HIP_MEMORY_SCOPE_AGENT); }
__device__ __forceinline__ unsigned xb_add(unsigned* p, unsigned v) { return __hip_atomic_fetch_add(p, v, __ATOMIC_RELAXED, __HIP_MEMORY_SCOPE_AGENT); }
__device__ __forceinline__ unsigned xb_xcc_id() { return (unsigned)__builtin_amdgcn_s_getreg((3 << 11) | 20) & 0xFu; }
#define XB_SPIN(cond, bar) do { unsigned _sp = 0; while (cond) { __builtin_amdgcn_s_sleep(1); \
    if ((++_sp & 255u) == 0u) { if (xb_ld(&(bar)[XB_TMO])) break; if (_sp > XB_SPIN_CAP) { atomicAdd(&(bar)[XB_TMO], 1u); break; } } } } while (0)
struct XcdBarrier { unsigned* bar; unsigned x; volatile LAS unsigned* st; };
__device__ __forceinline__ XcdBarrier xcd_barrier_post(unsigned* bar, volatile LAS unsigned* st) {
    XcdBarrier b; b.bar = bar; b.x = xb_xcc_id(); b.st = st;
    if (threadIdx.x == 0) (void)xb_add(&bar[XB_XCNT(b.x)], 1u);
    return b;
}
__device__ __forceinline__ void xcd_barrier_complete(unsigned* bar, unsigned x, unsigned& nloc, unsigned& nx) {
    const unsigned G = gridDim.x * gridDim.y * gridDim.z;
    unsigned sum, cnt, mine, sp = 0u;
    for (;;) {
        sum = 0u; cnt = 0u; mine = 0u;
#pragma unroll
        for (unsigned j = 0; j < 16; ++j) { const unsigned c = xb_ld(&bar[XB_XCNT(j)]); sum += c; cnt += (c > 0u) ? 1u : 0u; mine = (j == x) ? c : mine; }
        if (sum == G) break;
        __builtin_amdgcn_s_sleep(1);
        if ((++sp & 255u) == 0u) { if (xb_ld(&bar[XB_TMO])) break; if (sp > XB_SPIN_CAP) { atomicAdd(&bar[XB_TMO], 1u); break; } }
    }
    nloc = mine > 0u ? mine : 1u; nx = cnt > 0u ? cnt : 1u;
}
__device__ __forceinline__ void xcd_barrier(const XcdBarrier& b) {
    asm volatile("s_waitcnt vmcnt(0)" ::: "memory");
    __syncthreads();
    if (threadIdx.x == 0) {
        unsigned* bar = b.bar;
        __builtin_amdgcn_s_waitcnt(0);
        unsigned nloc = b.st[0], nx = b.st[1];
        if (nloc == 0u) { xcd_barrier_complete(bar, b.x, nloc, nx); b.st[0] = nloc; b.st[1] = nx; }
        const unsigned old = xb_add(&bar[XB_XSUB(b.x)], 1u);
        const unsigned gen = old / nloc;
        if (old + 1u == (gen + 1u) * nloc) {
            __builtin_amdgcn_fence(__ATOMIC_RELEASE, "agent");
            asm volatile("s_waitcnt vmcnt(0)" ::: "memory");
            const unsigned og = xb_add(&bar[XB_TOP], 1u);
            const unsigned tg = og / nx;
            if (og + 1u == (tg + 1u) * nx) xb_add(&bar[XB_TOPGEN], 1u);
            else XB_SPIN(xb_ld(&bar[XB_TOPGEN]) == tg, bar);
            __builtin_amdgcn_fence(__ATOMIC_ACQUIRE, "agent");
            xb_add(&bar[XB_XGEN(b.x)], 1u);
            asm volatile("s_waitcnt vmcnt(0)" ::: "memory");
        } else {
            XB_SPIN(xb_ld(&bar[XB_XGEN(b.x)]) == gen, bar);
            __builtin_amdgcn_fence(__ATOMIC_ACQUIRE, "agent");
            asm volatile("s_waitcnt vmcnt(0)" ::: "memory");
        }
    }
    __syncthreads();
}

struct Args {
    const float* in[34];
    float* out;
    unsigned char* ws;
    int ph_lo, ph_hi;
};

enum { I_X = 0, I_C, I_RELB, I_EADAW, I_EADAB, I_EN1, I_EINW, I_EQN, I_EKN, I_ESINK, I_EOUTW, I_EN2, I_EF1, I_EF3, I_EF2,
       I_OADAW, I_OADAB, I_ON1, I_OINW, I_OCONVW, I_OCONVB, I_ODTBF, I_ODTBB, I_OALF, I_OALB, I_OD, I_OGN, I_OOUTW, I_ON2, I_ORW, I_ORB, I_OM1, I_OM3, I_OM2 };

struct Frame {
    LAS unsigned char* lds;
    unsigned char* ws;
    int tid, lane, wave, G, vcu;
};

__device__ __forceinline__ void tr_item(const float* src  , int srcN, int k0, int n0, bf16* dstrow  , int dstK, LAS float* scr, int lane) {
#pragma unroll 8
    for (int i = 0; i < 32; ++i) { const int kk = 2 * i + (lane >> 5); scr[kk * 33 + (lane & 31)] = src[(size_t)(k0 + kk) * srcN + n0 + (lane & 31)]; }
    LDS_WAIT(); asm volatile("" ::: "memory");
    const int c = lane & 7;
#pragma unroll
    for (int j = 0; j < 4; ++j) { const int n = (lane >> 3) + 8 * j; const LAS float* s = scr + (8 * c) * 33 + n;
        u32x4 o; o.x = pk2(s[0 * 33], s[1 * 33]); o.y = pk2(s[2 * 33], s[3 * 33]); o.z = pk2(s[4 * 33], s[5 * 33]); o.w = pk2(s[6 * 33], s[7 * 33]);
        *(u32x4*)(dstrow + (size_t)n * dstK + k0 + 8 * c) = o; }
    LDS_WAIT(); asm volatile("" ::: "memory");
}

__device__ __forceinline__ void tr_item_fp8(const float* src, int srcN, int k0, int n0, unsigned char* dstrow, int dstK, LAS float* scr, int lane) {
#pragma unroll 8
    for (int i = 0; i < 32; ++i) { const int kk = 2 * i + (lane >> 5); scr[kk * 33 + (lane & 31)] = src[(size_t)(k0 + kk) * srcN + n0 + (lane & 31)]; }
    LDS_WAIT(); asm volatile("" ::: "memory");
    const int c = lane & 3;
#pragma unroll
    for (int j = 0; j < 2; ++j) { const int n = (lane >> 2) + 16 * j; const LAS float* s = scr + (16 * c) * 33 + n;
        u32x4 o;
        o.x = pk4_fp8(64.f * s[0 * 33], 64.f * s[1 * 33], 64.f * s[2 * 33], 64.f * s[3 * 33]); o.y = pk4_fp8(64.f * s[4 * 33], 64.f * s[5 * 33], 64.f * s[6 * 33], 64.f * s[7 * 33]);
        o.z = pk4_fp8(64.f * s[8 * 33], 64.f * s[9 * 33], 64.f * s[10 * 33], 64.f * s[11 * 33]); o.w = pk4_fp8(64.f * s[12 * 33], 64.f * s[13 * 33], 64.f * s[14 * 33], 64.f * s[15 * 33]);
        *(u32x4*)(dstrow + (size_t)n * dstK + k0 + 16 * c) = o; }
    LDS_WAIT(); asm volatile("" ::: "memory");
}

__device__ __forceinline__ void p0_prologue(const Frame& F, const Args& A) {
    const int tid = F.tid, lane = F.lane, wave = F.wave;
    unsigned char* ws = F.ws;
    if (blockIdx.x < 128) {
        const int it = blockIdx.x, kb = it & 15, part = (it >> 4) & 1, g = it >> 5;
        LAS float* tile = (LAS float*)F.lds;
        LAS float* ctab = (LAS float*)(F.lds + 32768);
        const float* Win = A.in[I_EINW];
        for (int i = tid; i < 64 * 128; i += 512) { const int kk = i >> 7, c = i & 127; tile[i] = Win[(size_t)(kb * 64 + kk) * 1280 + g * 128 + c]; }
        if (tid < 128) { const float ang = (float)tid * (6.283185307179586f / 128.0f); ctab[tid] = (part ? sinf(ang) : cosf(ang)) * 0.08838834764831845f; }
        __syncthreads();
        const int m = tid & 127, kq = tid >> 7;
        float accv[16];
#pragma unroll
        for (int j = 0; j < 16; ++j) accv[j] = 0.f;
        for (int c = 0; c < 128; ++c) { const float w = ctab[(m * c) & 127];
#pragma unroll
            for (int j = 0; j < 16; ++j) accv[j] += tile[(kq * 16 + j) * 128 + c] * w; }
        bf16* WU = (bf16*)(ws + WS_WU);
        u32x4 o0, o1;
        o0.x = pk2(accv[0], accv[1]); o0.y = pk2(accv[2], accv[3]); o0.z = pk2(accv[4], accv[5]); o0.w = pk2(accv[6], accv[7]);
        o1.x = pk2(accv[8], accv[9]); o1.y = pk2(accv[10], accv[11]); o1.z = pk2(accv[12], accv[13]); o1.w = pk2(accv[14], accv[15]);
        bf16* dst = WU + (size_t)(part * 512 + g * 128 + m) * 1024 + kb * 64 + kq * 16;
        *(u32x4*)dst = o0; *(u32x4*)(dst + 8) = o1;
        __syncthreads();
    }
    {
        LAS float* ct = (LAS float*)F.lds;
        for (int j = tid; j < 2048; j += 512) ct[j] = cosf((float)j * (6.283185307179586f / 2048.0f)) * 0.022097086912079608f;
        __syncthreads();
        bf16* FD = (bf16*)(ws + WS_FDFT);
        const int nchunk = 2048 * 4096 / 8;
        for (int ch = blockIdx.x * 512 + tid; ch < nchunk; ch += F.G * 512) {
            const int k = ch >> 9, c0 = (ch & 511) * 8;
            float v[8];
#pragma unroll
            for (int e = 0; e < 8; ++e) { const int cc = c0 + e; if (cc < 2048) v[e] = ct[(k * cc) & 2047]; else v[e] = -ct[((k * (cc - 2048)) - 512) & 2047]; }
            u32x4 o; o.x = pk2(v[0], v[1]); o.y = pk2(v[2], v[3]); o.z = pk2(v[4], v[5]); o.w = pk2(v[6], v[7]);
            *(u32x4*)(FD + (size_t)k * 4096 + c0) = o;
        }
        __syncthreads();
    }
    const int gw = F.vcu * 8 + wave, NGW = F.G * 8;
    {
        float* MODP = (float*)(ws + WS_MODP);
        for (int it = gw; it < 192 * 16; it += NGW) {
            const int cg = it % 192, ks = it / 192, l = cg / 96, col = (cg % 96) * 64 + lane;
            const float* W = A.in[l ? I_OADAW : I_EADAW];
            float cs[8], acc8[8];
#pragma unroll
            for (int b = 0; b < 8; ++b) { cs[b] = siluf(A.in[I_C][b * 1024 + ks * 64 + lane]); acc8[b] = 0.f; }
#pragma unroll 8
            for (int kk = 0; kk < 64; ++kk) { const float w = W[(size_t)(ks * 64 + kk) * 6144 + col];
#pragma unroll
                for (int b = 0; b < 8; ++b) acc8[b] += __shfl(cs[b], kk) * w; }
#pragma unroll
            for (int b = 0; b < 8; ++b) MODP[(size_t)ks * 98304 + l * 49152 + b * 6144 + col] = acc8[b];
        }
    }
    {
        LAS float* scr = (LAS float*)(F.lds + wave * 16384);
        constexpr int N1 = 16 * 24, N2 = 16 * 32, N3 = 16 * 88, N5 = 44 * 32, N6 = 16 * 162, N7 = 32 * 32, N8 = 8 * 16 * 112, N10 = 8 * 56 * 32;
        constexpr int NIT = N1 + N2 + 2 * N3 + N5 + N6 + N7 + 2 * N8 + N10;
        for (int it = gw; it < NIT; it += NGW) {
            int r = it;
            if (r < N1) { const int kb = r / 24, nb = r % 24; tr_item(A.in[I_EINW] + 512, 1280, kb * 64, nb * 32, (bf16*)(ws + WS_WQKV) + (size_t)(nb * 32) * 1024, 1024, scr, lane); continue; } r -= N1;
            if (r < N2) { const int kb = r / 32, nb = r % 32; tr_item(A.in[I_EOUTW], 1024, kb * 64, nb * 32, (bf16*)(ws + WS_WO0) + (size_t)(nb * 32) * 1024, 1024, scr, lane); continue; } r -= N2;
            if (r < 2 * N3) { const int w3 = r >= N3; if (w3) r -= N3; const int kb = r / 88, nb = r % 88, n0 = nb * 32, drow = (n0 >> 7) * 256 + (n0 & 127) + (w3 ? 128 : 0);
                tr_item(A.in[w3 ? I_EF3 : I_EF1], DFF, kb * 64, n0, (bf16*)(ws + WS_WF13) + (size_t)drow * 1024, 1024, scr, lane); continue; } r -= 2 * N3;
            if (r < N5) { const int kb = r / 32, nb = r % 32; tr_item(A.in[I_EF2], 1024, kb * 64, nb * 32, (bf16*)(ws + WS_WF2) + (size_t)(nb * 32) * DFF, DFF, scr, lane); continue; } r -= N5;
            if (r < N6) { const int kb = r / 162, nb = r % 162; tr_item(A.in[I_OINW], 5184, kb * 64, nb * 32, (bf16*)(ws + WS_WSIN) + (size_t)(nb * 32) * 1024, 1024, scr, lane); continue; } r -= N6;
            if (r < N7) { const int kb = r / 32, nb = r % 32; tr_item(A.in[I_OOUTW], 1024, kb * 64, nb * 32, (bf16*)(ws + WS_WSOUT) + (size_t)(nb * 32) * 2048, 2048, scr, lane); continue; } r -= N7;
            if (r < 2 * N8) { const int w3 = r >= N8; if (w3) r -= N8; const int e = r / (16 * 112); r %= 16 * 112; const int kb = r / 112, nb = r % 112, n0 = nb * 32, drow = (n0 >> 7) * 256 + (n0 & 127) + (w3 ? 128 : 0);
                tr_item_fp8(A.in[w3 ? I_OM3 : I_OM1] + (size_t)e * 1024 * DFE, DFE, kb * 64, n0, (unsigned char*)(ws + WS_WM13) + ((size_t)e * 7168 + drow) * 1024, 1024, scr, lane); continue; } r -= 2 * N8;
            { const int e = r / (56 * 32); r %= 56 * 32; const int kb = r / 32, nb = r % 32;
                tr_item_fp8(A.in[I_OM2] + (size_t)e * DFE * 1024, 1024, kb * 64, nb * 32, (unsigned char*)(ws + WS_WM2) + ((size_t)e * 1024 + nb * 32) * DFE, DFE, scr, lane); }
        }
    }
}

template <int MODE>
__device__ __forceinline__ void modulate_phase(const Frame& F, const Args& A, const float* xsrc, const float* normw, int layer, int which  ) {
    const int tid = F.tid, lane = F.lane, wave = F.wave;
    unsigned char* ws = F.ws;
    LAS float* sh = (LAS float*)F.lds;
    LAS float* sc = sh + 1024;
    LAS float* nw = sc + 1024;
    LAS float* rw = nw + 1024;
    LAS int* lcnt = (LAS int*)(rw + 8192);
    LAS int* gbase = lcnt + 8;
    LAS int* sel_e = gbase + 8;
    LAS int* sel_p = sel_e + 128;
    LAS float* sel_w = (LAS float*)(sel_p + 128);
    const float* MODP = (const float*)(ws + WS_MODP);
    float* MOD = (float*)(ws + WS_MOD);
    bf16* XN = (bf16*)(ws + WS_XN);
    for (int blk = blockIdx.x; blk < T / 64; blk += F.G) {
        const int row0 = blk * 64, b = row0 / SEQ;
        __syncthreads();
        for (int i = tid; i < 2048; i += 512) {
            const int idx = layer * 49152 + b * 6144 + which * 3072 + i;
            float v;
            if (MODE == 0) { v = A.in[I_EADAB][which * 3072 + i];
#pragma unroll
                for (int ks = 0; ks < 16; ++ks) v += MODP[(size_t)ks * 98304 + idx]; }
            else v = MOD[idx];
            sh[i] = v;
        }
        for (int i = tid; i < 1024; i += 512) nw[i] = normw[i];
        if (MODE == 2) { for (int i = tid; i < 8192; i += 512) { const int e = i >> 10, c = i & 1023; rw[i] = A.in[I_ORW][c * 8 + e]; } if (tid < 8) lcnt[tid] = 0; }
        __syncthreads();
        for (int rr = 0; rr < 8; ++rr) {
            const int lr = wave * 8 + rr, row = row0 + lr;
            const GAS f32x4* xr = (const GAS f32x4*)(xsrc + (size_t)row * D) + lane;
            f32x4 v[4]; float ss = 0.f;
#pragma unroll
            for (int j = 0; j < 4; ++j) { v[j] = xr[64 * j]; ss += (v[j].x * v[j].x + v[j].y * v[j].y) + (v[j].z * v[j].z + v[j].w * v[j].w); }
            const float rstd = 1.0f / sqrtf(wave_sum(ss) * (1.0f / D) + EPS);
            GAS unsigned long long* o8 = (GAS unsigned long long*)(XN + (size_t)row * D) + lane;
            float lg[8];
            if (MODE == 2) {
#pragma unroll
                for (int e = 0; e < 8; ++e) lg[e] = 0.f; }
#pragma unroll
            for (int j = 0; j < 4; ++j) {
                const int c = 4 * lane + 256 * j;
                const f32x4 w4 = *(const LAS f32x4*)(nw + c), s4 = *(const LAS f32x4*)(sc + c), h4 = *(const LAS f32x4*)(sh + c);
                f32x4 y;
                y.x = v[j].x * rstd * w4.x * (1.0f + s4.x) + h4.x; y.y = v[j].y * rstd * w4.y * (1.0f + s4.y) + h4.y;
                y.z = v[j].z * rstd * w4.z * (1.0f + s4.z) + h4.z; y.w = v[j].w * rstd * w4.w * (1.0f + s4.w) + h4.w;
                if (MODE == 2) ((GAS unsigned*)((unsigned char*)XN + (size_t)row * D))[lane + 64 * j] = pk4_fp8(y.x, y.y, y.z, y.w);
                else o8[64 * j] = (unsigned long long)pk2(y.x, y.y) | ((unsigned long long)pk2(y.z, y.w) << 32);
                if (MODE == 2) {
#pragma unroll
                    for (int e = 0; e < 8; ++e) { const f32x4 r4 = *(const LAS f32x4*)(rw + e * 1024 + c); lg[e] += (y.x * r4.x + y.y * r4.y) + (y.z * r4.z + y.w * r4.w); } }
            }
            if (MODE == 2) {
#pragma unroll
                for (int e = 0; e < 8; ++e) lg[e] = wave_sum(lg[e]) + A.in[I_ORB][e];
                int i0 = 0; float v0 = lg[0];
#pragma unroll
                for (int e = 1; e < 8; ++e) if (lg[e] > v0) { v0 = lg[e]; i0 = e; }
                int i1 = -1; float v1 = -3.0e38f;
#pragma unroll
                for (int e = 0; e < 8; ++e) if (e != i0 && lg[e] > v1) { v1 = lg[e]; i1 = e; }
                const float w0 = 1.0f / (1.0f + __expf(v1 - v0)), w1 = 1.0f - w0;
                if (lane == 0) {
                    sel_e[lr * 2] = i0; sel_e[lr * 2 + 1] = i1; sel_w[lr * 2] = w0; sel_w[lr * 2 + 1] = w1;
                    sel_p[lr * 2] = __hip_atomic_fetch_add(lcnt + i0, 1, __ATOMIC_RELAXED, __HIP_MEMORY_SCOPE_WORKGROUP);
                    sel_p[lr * 2 + 1] = __hip_atomic_fetch_add(lcnt + i1, 1, __ATOMIC_RELAXED, __HIP_MEMORY_SCOPE_WORKGROUP);
                }
            }
        }
        if (MODE == 2) {
            __syncthreads();
            unsigned* gcnt = (unsigned*)(ws + WS_CTL) + CW_GCNT;
            if (tid < 8) gbase[tid] = (int)__hip_atomic_fetch_add(gcnt + tid, (unsigned)lcnt[tid], __ATOMIC_RELAXED, __HIP_MEMORY_SCOPE_AGENT);
            __syncthreads();
            if (tid < 128) { const int tok = row0 + (tid >> 1), k = tid & 1, e = sel_e[tid];
                ((int*)(ws + WS_ROUTE + RT_TOKE))[tok * 2 + k] = e;
                ((int*)(ws + WS_ROUTE + RT_TOKP))[tok * 2 + k] = gbase[e] + sel_p[tid];
                ((float*)(ws + WS_ROUTE + RT_TOKW))[tok * 2 + k] = sel_w[tid]; }
        }
    }
    if (MODE == 0) {
        const int idx = blockIdx.x * 384 + tid;
        if (tid < 384 && idx < 98304) { const int l = idx / 49152, col = idx % 6144; float v = A.in[l ? I_OADAB : I_EADAB][col];
#pragma unroll
            for (int ks = 0; ks < 16; ++ks) v += MODP[(size_t)ks * 98304 + idx];
            MOD[idx] = v; }
    }
}

struct SchedPlain {
    const char* A; const char* B; int nM, nN, G, c; size_t tstep;
    __device__ __forceinline__ bool next(int i, Unit& u) const { int pm, pn; if (!pg8::tile_order(i, G, c, nM, nN, pm, pn)) return false; u.pm = pm; u.pn = pn; u.a = A + (size_t)pm * tstep; u.b = B + (size_t)pn * tstep; return true; }
};
struct SchedFourier {
    const char* Fm; const char* UT; int unit;
    __device__ __forceinline__ bool next(int i, Unit& u) const { if (i != 0 || unit < 0) return false; const int b = unit >> 4, idx = unit & 15; u.pm = b * 8 + (idx & 7); u.pn = idx >> 3;
        u.a = Fm + (size_t)(idx & 7) * 256 * 4096 * 2; u.b = UT + ((size_t)b * 512 + (size_t)(idx >> 3) * 256) * 4096 * 2; return true; }
};
struct SchedMoe {
    const char* A; const char* B; const LAS int* pexp; int nM, nN, G, c; size_t tstepA, tstepB; int tiles_per_exp;
    __device__ __forceinline__ bool next(int i, Unit& u) const { int pm, pn; if (!pg8::tile_order(i, G, c, nM, nN, pm, pn)) return false; u.pm = pm; u.pn = pn; const int e = pexp[pm];
        u.a = A + (size_t)pm * tstepA; u.b = B + (size_t)(e * tiles_per_exp + pn) * tstepB; return true; }
};

struct EpiBf16 {
    static constexpr bool PERM = true, FP8 = false;
    bf16* O; int ldc;
    __device__ __forceinline__ void operator()(const f32x4 (&acc)[2][2][4][2], const Unit& u, int wr, int wc, int fr, int fq) const {
        const int row0 = u.pm * 256 + wr * 64 + fr, col0 = u.pn * 256 + wc * 32 + 8 * fq;
#pragma unroll
        for (int ai = 0; ai < 2; ++ai)
#pragma unroll
            for (int m = 0; m < 4; ++m) { bf16* rowp = O + (size_t)(row0 + ai * 128 + m * 16) * ldc + col0;
#pragma unroll
                for (int bj = 0; bj < 2; ++bj) { const f32x4 v0 = acc[ai][bj][m][0], v1 = acc[ai][bj][m][1];
                    u32x4 w; w.x = pk2(v0[0], v0[1]); w.y = pk2(v0[2], v0[3]); w.z = pk2(v1[0], v1[1]); w.w = pk2(v1[2], v1[3]);
                    *(u32x4*)(rowp + bj * 128) = w; } }
    }
};
struct EpiUT {
    static constexpr bool PERM = true, FP8 = false;
    bf16* UT;
    __device__ __forceinline__ void operator()(const f32x4 (&acc)[2][2][4][2], const Unit& u, int wr, int wc, int fr, int fq) const {
        const int part = u.pm >> 1, c0 = (u.pm & 1) * 256 + wr * 64 + fr, b = u.pn >> 3, s0 = (u.pn & 7) * 256 + wc * 32 + 8 * fq;
        bf16* base = UT + ((size_t)b * 512) * 4096 + part * 2048 + s0;
#pragma unroll
        for (int ai = 0; ai < 2; ++ai)
#pragma unroll
            for (int m = 0; m < 4; ++m) { bf16* rowp = base + (size_t)(c0 + ai * 128 + m * 16) * 4096;
#pragma unroll
                for (int bj = 0; bj < 2; ++bj) { const f32x4 v0 = acc[ai][bj][m][0], v1 = acc[ai][bj][m][1];
                    u32x4 w; w.x = pk2(v0[0], v0[1]); w.y = pk2(v0[2], v0[3]); w.z = pk2(v1[0], v1[1]); w.w = pk2(v1[2], v1[3]);
                    *(u32x4*)(rowp + bj * 128) = w; } }
    }
};
struct EpiRes {
    static constexpr bool PERM = false, FP8 = false;
    const float* base; float* out; const float* g;
    __device__ __forceinline__ void operator()(const f32x4 (&acc)[2][2][4][2], const Unit& u, int wr, int wc, int fr, int fq) const {
        const int row0 = u.pm * 256 + wr * 64 + fr, col0 = u.pn * 256 + wc * 32 + 4 * fq, b = (u.pm * 256) / SEQ;
        f32x4 gv[2][2];
#pragma unroll
        for (int bj = 0; bj < 2; ++bj)
#pragma unroll
            for (int n = 0; n < 2; ++n) gv[bj][n] = *(const f32x4*)(g + b * 6144 + col0 + bj * 128 + n * 16);
#pragma unroll
        for (int ai = 0; ai < 2; ++ai)
#pragma unroll
            for (int m = 0; m < 4; ++m) { const size_t off = (size_t)(row0 + ai * 128 + m * 16) * D + col0;
#pragma unroll
                for (int bj = 0; bj < 2; ++bj)
#pragma unroll
                    for (int n = 0; n < 2; ++n) { const f32x4 bs = *(const f32x4*)(base + off + bj * 128 + n * 16);
                        *(f32x4*)(out + off + bj * 128 + n * 16) = bs + gv[bj][n] * acc[ai][bj][m][n]; } }
    }
};
struct EpiSwiglu {
    static constexpr bool PERM = true, FP8 = false;
    bf16* H; int ldc;
    __device__ __forceinline__ void operator()(const f32x4 (&acc)[2][2][4][2], const Unit& u, int wr, int wc, int fr, int fq) const {
        const int row0 = u.pm * 256 + wr * 64 + fr, col0 = u.pn * 128 + wc * 32 + 8 * fq;
#pragma unroll
        for (int ai = 0; ai < 2; ++ai)
#pragma unroll
            for (int m = 0; m < 4; ++m) { bf16* rowp = H + (size_t)(row0 + ai * 128 + m * 16) * ldc + col0;
                float h[8];
#pragma unroll
                for (int n = 0; n < 2; ++n)
#pragma unroll
                    for (int j = 0; j < 4; ++j) { const float a = acc[ai][0][m][n][j], bb = acc[ai][1][m][n][j]; h[n * 4 + j] = a / (1.0f + __expf(-a)) * bb; }
                u32x4 w; w.x = pk2(h[0], h[1]); w.y = pk2(h[2], h[3]); w.z = pk2(h[4], h[5]); w.w = pk2(h[6], h[7]);
                *(u32x4*)rowp = w; }
    }
};
struct EpiSwiglu8 {
    static constexpr bool PERM = true, FP8 = true;
    unsigned char* H; int ldc;
    __device__ __forceinline__ void operator()(const f32x4 (&acc)[2][2][4][2], const Unit& u, int wr, int wc, int fr, int fq) const {
        const int row0 = u.pm * 256 + wr * 64 + fr, col0 = u.pn * 128 + wc * 32 + 8 * fq;
#pragma unroll
        for (int ai = 0; ai < 2; ++ai)
#pragma unroll
            for (int m = 0; m < 4; ++m) { unsigned char* rowp = H + (size_t)(row0 + ai * 128 + m * 16) * ldc + col0;
                float h[8];
#pragma unroll
                for (int n = 0; n < 2; ++n)
#pragma unroll
                    for (int j = 0; j < 4; ++j) { const float a = acc[ai][0][m][n][j] * 0.015625f, bb = acc[ai][1][m][n][j] * 0.015625f; h[n * 4 + j] = a / (1.0f + __expf(-a)) * bb; }
                u32x2 w; w.x = pk4_fp8(h[0], h[1], h[2], h[3]); w.y = pk4_fp8(h[4], h[5], h[6], h[7]);
                *(u32x2*)rowp = w; }
    }
};
struct EpiSsmIn {
    static constexpr bool PERM = true, FP8 = false;
    bf16* Z; bf16* XBC;
    __device__ __forceinline__ void operator()(const f32x4 (&acc)[2][2][4][2], const Unit& u, int wr, int wc, int fr, int fq) const {
        const int row0 = u.pm * 256 + wr * 64 + fr; const bool isz = u.pn < 8;
        bf16* O = isz ? Z : XBC; const int ldc = isz ? 2048 : 3072, col0 = (isz ? u.pn : u.pn - 8) * 256 + wc * 32 + 8 * fq;
#pragma unroll
        for (int ai = 0; ai < 2; ++ai)
#pragma unroll
            for (int m = 0; m < 4; ++m) { bf16* rowp = O + (size_t)(row0 + ai * 128 + m * 16) * ldc + col0;
#pragma unroll
                for (int bj = 0; bj < 2; ++bj) { const f32x4 v0 = acc[ai][bj][m][0], v1 = acc[ai][bj][m][1];
                    u32x4 w; w.x = pk2(v0[0], v0[1]); w.y = pk2(v0[2], v0[3]); w.z = pk2(v1[0], v1[1]); w.w = pk2(v1[2], v1[3]);
                    *(u32x4*)(rowp + bj * 128) = w; } }
    }
};
struct EpiMoeSlot {
    static constexpr bool PERM = true, FP8 = true;
    bf16* YS; const int* rowdst;
    __device__ __forceinline__ void operator()(const f32x4 (&acc)[2][2][4][2], const Unit& u, int wr, int wc, int fr, int fq) const {
        const int row0 = u.pm * 256 + wr * 64 + fr, col0 = u.pn * 256 + wc * 32 + 8 * fq;
#pragma unroll
        for (int ai = 0; ai < 2; ++ai)
#pragma unroll
            for (int m = 0; m < 4; ++m) { const int dst = rowdst[row0 + ai * 128 + m * 16];
                if (dst >= 0) { bf16* rowp = YS + (size_t)dst * D + col0;
#pragma unroll
                    for (int bj = 0; bj < 2; ++bj) { const f32x4 v0 = acc[ai][bj][m][0], v1 = acc[ai][bj][m][1];
                        u32x4 w; w.x = pk2(v0[0] * 0.015625f, v0[1] * 0.015625f); w.y = pk2(v0[2] * 0.015625f, v0[3] * 0.015625f); w.z = pk2(v1[0] * 0.015625f, v1[1] * 0.015625f); w.w = pk2(v1[2] * 0.015625f, v1[3] * 0.015625f);
                        *(u32x4*)(rowp + bj * 128) = w; } } }
    }
};

__device__ __forceinline__ int t5_bucket(int rel) {
    const int n = rel < 0 ? -rel : rel;
    int v = n < 8 ? n : n < 12 ? 8 : n < 16 ? 9 : n < 23 ? 10 : n < 32 ? 11 : n < 46 ? 12 : n < 64 ? 13 : n < 91 ? 14 : 15;
    return (rel > 0 ? 16 : 0) + v;
}
__device__ __forceinline__ void attn_unit(const Frame& F, const Args& A, int b, int nb, int kvh) {
    const int tid = F.tid, lane = F.lane, wave = F.wave, l31 = lane & 31, hh = lane >> 5;
    LAS bf16* Kn = (LAS bf16*)F.lds;
    LAS bf16* VT = (LAS bf16*)(F.lds + 55296);
    LAS float* btab = (LAS float*)(F.lds + 55296 + 50176);
    const bf16* QKV = (const bf16*)(F.ws + WS_QKV);
    bf16* Y = (bf16*)(F.ws + WS_Y0);
    __syncthreads();
    for (int i = 0; i < 6; ++i) {
        const int cid = tid + 512 * i, j = cid >> 3, ch = cid & 7, kpos = nb * 128 - 128 + j;
        const bool ok = kpos >= 0 && kpos < SEQ;
        u32x4 kv = (u32x4){0u, 0u, 0u, 0u}, vv = kv;
        if (ok) { const bf16* rowp = QKV + (size_t)(b * SEQ + kpos) * QKVW; kv = *(const u32x4*)(rowp + 512 + kvh * 64 + ch * 8); vv = *(const u32x4*)(rowp + 640 + kvh * 64 + ch * 8); }
        float kf[8] = {bflo(kv.x), bfhi(kv.x), bflo(kv.y), bfhi(kv.y), bflo(kv.z), bfhi(kv.z), bflo(kv.w), bfhi(kv.w)};
        float ss = 0.f;
#pragma unroll
        for (int e = 0; e < 8; ++e) ss += kf[e] * kf[e];
        ss += __shfl_xor(ss, 1); ss += __shfl_xor(ss, 2); ss += __shfl_xor(ss, 4);
        const float rstd = 1.0f / sqrtf(ss * (1.0f / 64.0f) + EPS);
        const float* kw = A.in[I_EKN] + ch * 8;
        u32x4 o; o.x = pk2(kf[0] * rstd * kw[0], kf[1] * rstd * kw[1]); o.y = pk2(kf[2] * rstd * kw[2], kf[3] * rstd * kw[3]);
        o.z = pk2(kf[4] * rstd * kw[4], kf[5] * rstd * kw[5]); o.w = pk2(kf[6] * rstd * kw[6], kf[7] * rstd * kw[7]);
        *(LAS u32x4*)(Kn + j * 72 + ch * 8) = o;
        const unsigned vw[4] = {vv.x, vv.y, vv.z, vv.w};
#pragma unroll
        for (int e = 0; e < 8; ++e) VT[(ch * 8 + e) * 392 + j] = (bf16)((e & 1) ? (vw[e >> 1] >> 16) : (vw[e >> 1] & 0xffffu));
    }
    for (int i = tid; i < 4 * 257; i += 512) { const int hq = i / 257, ri = i % 257; btab[hq * 260 + ri] = A.in[I_RELB][t5_bucket(ri - 128) * 8 + kvh * 4 + hq]; }
    __syncthreads();
    for (int itn = 0; itn < 2; ++itn) {
        const int it = wave + 8 * itn, hq = it >> 2, rb = it & 3, head = kvh * 4 + hq;
        const int qi = 32 * rb + l31, tok = b * SEQ + nb * 128 + qi;
        bf16x8 Qf[4];
        {
            u32x4 qv[4]; float ss = 0.f;
#pragma unroll
            for (int ks = 0; ks < 4; ++ks) { qv[ks] = *(const u32x4*)(QKV + (size_t)tok * QKVW + head * 64 + 16 * ks + 8 * hh);
                const unsigned w[4] = {qv[ks].x, qv[ks].y, qv[ks].z, qv[ks].w};
#pragma unroll
                for (int e = 0; e < 4; ++e) { const float a = bflo(w[e]), c = bfhi(w[e]); ss += a * a + c * c; } }
            ss += __shfl_xor(ss, 32);
            const float rstd = 0.125f / sqrtf(ss * (1.0f / 64.0f) + EPS);
#pragma unroll
            for (int ks = 0; ks < 4; ++ks) { const float* qw = A.in[I_EQN] + 16 * ks + 8 * hh; const unsigned w[4] = {qv[ks].x, qv[ks].y, qv[ks].z, qv[ks].w};
                u32x4 o; o.x = pk2(bflo(w[0]) * rstd * qw[0], bfhi(w[0]) * rstd * qw[1]); o.y = pk2(bflo(w[1]) * rstd * qw[2], bfhi(w[1]) * rstd * qw[3]);
                o.z = pk2(bflo(w[2]) * rstd * qw[4], bfhi(w[2]) * rstd * qw[5]); o.w = pk2(bflo(w[3]) * rstd * qw[6], bfhi(w[3]) * rstd * qw[7]);
                Qf[ks] = __builtin_bit_cast(bf16x8, o); }
        }
        float mrun = A.in[I_ESINK][head], lsum = hh ? 0.f : 1.0f;
        f32x16 O0, O1;
#pragma unroll
        for (int r = 0; r < 16; ++r) { O0[r] = 0.f; O1[r] = 0.f; }
        for (int tg = 0; tg < 3; ++tg) {
            f32x16 Sa[3];
#pragma unroll
            for (int kt = 0; kt < 3; ++kt) { const int jt = rb + 3 * tg + kt;
#pragma unroll
                for (int r = 0; r < 16; ++r) Sa[kt][r] = 0.f;
#pragma unroll
                for (int ks = 0; ks < 4; ++ks) { const bf16x8 kfr = *(const LAS bf16x8*)(Kn + (32 * jt + l31) * 72 + 16 * ks + 8 * hh);
                    Sa[kt] = __builtin_amdgcn_mfma_f32_32x32x16_bf16(kfr, Qf[ks], Sa[kt], 0, 0, 0); } }
            float gmax = -3.0e38f;
#pragma unroll
            for (int kt = 0; kt < 3; ++kt) { const int jt = rb + 3 * tg + kt;
#pragma unroll
                for (int r = 0; r < 16; ++r) { const int j = 32 * jt + (r & 3) + 8 * (r >> 2) + 4 * hh, rel = j - 128 - qi, kpos = nb * 128 - 128 + j;
                    const bool ok = rel >= -128 && rel <= 128 && kpos >= 0 && kpos < SEQ;
                    const int ridx = ok ? rel + 128 : 0;
                    const float s = ok ? Sa[kt][r] + btab[hq * 260 + ridx] : -INFINITY;
                    Sa[kt][r] = s; gmax = fmaxf(gmax, s); } }
            gmax = fmaxf(gmax, __shfl_xor(gmax, 32));
            const float mnew = fmaxf(mrun, gmax), alpha = __expf(mrun - mnew); mrun = mnew;
            float psum = 0.f;
#pragma unroll
            for (int kt = 0; kt < 3; ++kt)
#pragma unroll
                for (int r = 0; r < 16; ++r) { const float p = __expf(Sa[kt][r] - mnew); Sa[kt][r] = p; psum += p; }
            lsum = lsum * alpha + psum;
#pragma unroll
            for (int r = 0; r < 16; ++r) { O0[r] *= alpha; O1[r] *= alpha; }
#pragma unroll
            for (int kt = 0; kt < 3; ++kt) { const int jt = rb + 3 * tg + kt;
#pragma unroll
                for (int s2 = 0; s2 < 2; ++s2) {
                    u32x4 pw; pw.x = pk2(Sa[kt][8 * s2 + 0], Sa[kt][8 * s2 + 1]); pw.y = pk2(Sa[kt][8 * s2 + 2], Sa[kt][8 * s2 + 3]);
                    pw.z = pk2(Sa[kt][8 * s2 + 4], Sa[kt][8 * s2 + 5]); pw.w = pk2(Sa[kt][8 * s2 + 6], Sa[kt][8 * s2 + 7]);
                    const bf16x8 pf = __builtin_bit_cast(bf16x8, pw);
                    const int kb = 32 * jt + 16 * s2 + 4 * hh;
                    { const u32x2 lo = *(const LAS u32x2*)(VT + l31 * 392 + kb), hi = *(const LAS u32x2*)(VT + l31 * 392 + kb + 8);
                      const u32x4 vw = (u32x4){lo.x, lo.y, hi.x, hi.y}; O0 = __builtin_amdgcn_mfma_f32_32x32x16_bf16(__builtin_bit_cast(bf16x8, vw), pf, O0, 0, 0, 0); }
                    { const u32x2 lo = *(const LAS u32x2*)(VT + (32 + l31) * 392 + kb), hi = *(const LAS u32x2*)(VT + (32 + l31) * 392 + kb + 8);
                      const u32x4 vw = (u32x4){lo.x, lo.y, hi.x, hi.y}; O1 = __builtin_amdgcn_mfma_f32_32x32x16_bf16(__builtin_bit_cast(bf16x8, vw), pf, O1, 0, 0, 0); }
                } }
        }
        lsum += __shfl_xor(lsum, 32);
        const float inv = 1.0f / lsum;
        bf16* yrow = Y + (size_t)tok * D + 512 + head * 64;
#pragma unroll
        for (int q4 = 0; q4 < 4; ++q4) {
            u32x2 w0, w1;
            w0.x = pk2(O0[4 * q4] * inv, O0[4 * q4 + 1] * inv); w0.y = pk2(O0[4 * q4 + 2] * inv, O0[4 * q4 + 3] * inv);
            w1.x = pk2(O1[4 * q4] * inv, O1[4 * q4 + 1] * inv); w1.y = pk2(O1[4 * q4 + 2] * inv, O1[4 * q4 + 3] * inv);
            *(u32x2*)(yrow + 8 * q4 + 4 * hh) = w0; *(u32x2*)(yrow + 32 + 8 * q4 + 4 * hh) = w1;
        }
    }
}

__device__ __forceinline__ void dt_phase(const Frame& F, const Args& A) {
    const int lane = F.lane, wave = F.wave, tid = F.tid, fr = lane & 15, fq = lane >> 4;
    const bf16* XN = (const bf16*)(F.ws + WS_XN);
    const bf16* Wdt = (const bf16*)(F.ws + WS_WSIN) + (size_t)5120 * 1024;
    float* DT = (float*)(F.ws + WS_DT);
    LAS float* part = (LAS float*)F.lds;
    for (int blk = blockIdx.x; blk < T / 64; blk += F.G) {
        const int row0 = blk * 64;
        f32x4 acc[4][4];
#pragma unroll
        for (int m = 0; m < 4; ++m)
#pragma unroll
            for (int n = 0; n < 4; ++n) acc[m][n] = (f32x4){0.f, 0.f, 0.f, 0.f};
#pragma unroll
        for (int ks = 0; ks < 4; ++ks) {
            const int k0 = wave * 128 + ks * 32 + fq * 8;
            bf16x8 af[4], bfm[4];
#pragma unroll
            for (int m = 0; m < 4; ++m) af[m] = *(const bf16x8*)(XN + (size_t)(row0 + m * 16 + fr) * D + k0);
#pragma unroll
            for (int n = 0; n < 4; ++n) bfm[n] = *(const bf16x8*)(Wdt + (size_t)(n * 16 + fr) * D + k0);
#pragma unroll
            for (int m = 0; m < 4; ++m)
#pragma unroll
                for (int n = 0; n < 4; ++n) acc[m][n] = __builtin_amdgcn_mfma_f32_16x16x32_bf16(af[m], bfm[n], acc[m][n], 0, 0, 0);
        }
        __syncthreads();
#pragma unroll
        for (int m = 0; m < 4; ++m)
#pragma unroll
            for (int n = 0; n < 4; ++n)
#pragma unroll
                for (int i = 0; i < 4; ++i) part[wave * 4096 + (m * 16 + 4 * fq + i) * 64 + n * 16 + fr] = acc[m][n][i];
        __syncthreads();
        for (int i = tid; i < 4096; i += 512) {
            float v = 0.f;
#pragma unroll
            for (int w = 0; w < 8; ++w) v += part[w * 4096 + i];
            const int col = i & 63;
            v += (col < 32) ? A.in[I_ODTBF][col] : A.in[I_ODTBB][col - 32];
            const float sp = v > 20.f ? v : log1pf(__expf(v));
            DT[(size_t)(row0 + (i >> 6)) * 64 + col] = sp;
        }
    }
}

constexpr int RS = 136;
constexpr int SL_BN = 0, SL_CN = 34816, SL_XT = 69632, SL_SC = 139264;
constexpr int SQ_BT = 0, SQ_XT = 34816, SQ_ST = 52224, SQ_E = 69632, SQ_W = 70144;
constexpr int SC_REC = 1536;

__device__ __forceinline__ bf16x8 pack8(const f32x16& v, int s2) {
    u32x4 w; w.x = pk2(v[8 * s2 + 0], v[8 * s2 + 1]); w.y = pk2(v[8 * s2 + 2], v[8 * s2 + 3]); w.z = pk2(v[8 * s2 + 4], v[8 * s2 + 5]); w.w = pk2(v[8 * s2 + 6], v[8 * s2 + 7]);
    return __builtin_bit_cast(bf16x8, w);
}

__device__ __forceinline__ void ssd_local_unit(const Frame& F, const Args& A, int b, int c, int g, int hf) {
    const int tid = F.tid, lane = F.lane, wave = F.wave, l31 = lane & 31, hh = lane >> 5;
    LAS bf16* Bn = (LAS bf16*)(F.lds + SL_BN); LAS bf16* Cn = (LAS bf16*)(F.lds + SL_CN); LAS bf16* XTl = (LAS bf16*)(F.lds + SL_XT);
    LAS float* scl = (LAS float*)(F.lds + SL_SC);
    const bf16* XBC = (const bf16*)(F.ws + WS_XBC);
    bf16* XTg = (bf16*)(F.ws + WS_XT); bf16* BTg = (bf16*)(F.ws + WS_BT); bf16* CNg = (bf16*)(F.ws + WS_CN);
    unsigned char* SCg = F.ws + WS_SC;
    const float* DT = (const float*)(F.ws + WS_DT);
    bf16* YM = (bf16*)(F.ws + WS_YM);
    const int recg = (b * 16 + c) * 4 + g;
    __syncthreads();
    for (int it = tid; it < 1024; it += 512) {
        const int ch8 = it & 63, tg = it >> 6, l0 = tg * 8;
        const int kind = ch8 < 16 ? 1 : (ch8 < 32 ? 2 : 0);
        const int xi = ch8 - 32, hl = xi >> 3;
        const int cc = kind == 1 ? ch8 * 8 : (kind == 2 ? (ch8 - 16) * 8 : (xi & 7) * 8);
        const int h = g * 8 + hf * 4 + hl;
        const int col = kind == 0 ? h * 64 + cc : (kind == 1 ? 2048 + g * 128 + cc : 2560 + g * 128 + cc);
        u32x4 inr[12];
#pragma unroll
        for (int r = 0; r < 12; ++r) { const int pos = c * 128 + l0 + r - 2;
            inr[r] = (u32x4){0u, 0u, 0u, 0u};
            if (pos >= 0 && pos < SEQ) inr[r] = *(const u32x4*)(XBC + (size_t)(b * SEQ + pos) * CDIM + col); }
        float o[8][8];
#pragma unroll
        for (int e = 0; e < 8; ++e) {
            float wv[5];
#pragma unroll
            for (int i = 0; i < 5; ++i) wv[i] = A.in[I_OCONVW][i * CDIM + col + e];
            const float bv = A.in[I_OCONVB][col + e];
            float xin[12];
#pragma unroll
            for (int r = 0; r < 12; ++r) { const unsigned w = (e >> 1) == 0 ? inr[r].x : ((e >> 1) == 1 ? inr[r].y : ((e >> 1) == 2 ? inr[r].z : inr[r].w)); xin[r] = (e & 1) ? bfhi(w) : bflo(w); }
#pragma unroll
            for (int t = 0; t < 8; ++t) { float sacc = bv;
#pragma unroll
                for (int i = 0; i < 5; ++i) sacc += xin[t + i] * wv[i];
                o[t][e] = sacc / (1.0f + __expf(-sacc)); }
        }
        if (kind != 0) {
            LAS bf16* Nn = kind == 1 ? Bn : Cn;
#pragma unroll
            for (int t = 0; t < 8; ++t) { u32x4 w; w.x = pk2(o[t][0], o[t][1]); w.y = pk2(o[t][2], o[t][3]); w.z = pk2(o[t][4], o[t][5]); w.w = pk2(o[t][6], o[t][7]);
                *(LAS u32x4*)(Nn + (l0 + t) * RS + cc) = w;
                if (kind == 2 && hf == 0) *(u32x4*)(CNg + (size_t)recg * 16384 + (l0 + t) * 128 + cc) = w; }
        }
        if (kind != 2) {
#pragma unroll
            for (int e = 0; e < 8; ++e) { u32x4 w; w.x = pk2(o[0][e], o[1][e]); w.y = pk2(o[2][e], o[3][e]); w.z = pk2(o[4][e], o[5][e]); w.w = pk2(o[6][e], o[7][e]);
                if (kind == 0) { *(LAS u32x4*)(XTl + hl * (64 * RS) + (cc + e) * RS + l0) = w;
                    *(u32x4*)(XTg + ((size_t)((b * 16 + c) * 32 + h)) * 8192 + (cc + e) * 128 + l0) = w; }
                else if (hf == 0) *(u32x4*)(BTg + (size_t)recg * 16384 + (cc + e) * 128 + l0) = w; }
        }
    }
    {
        const int hl = wave >> 1, dir = wave & 1, h = g * 8 + hf * 4 + hl;
        LAS float* dtv = scl + hl * 512 + dir * 128;
        LAS float* cum = scl + hl * 512 + 256 + dir * 128;
        unsigned char* rec = SCg + (size_t)((b * 16 + c) * 32 + h) * SC_REC;
        const float Ah = -__expf(A.in[dir ? I_OALB : I_OALF][h]);
        const float d0 = DT[(size_t)(b * SEQ + c * 128 + 2 * lane) * 64 + dir * 32 + h], d1 = DT[(size_t)(b * SEQ + c * 128 + 2 * lane + 1) * 64 + dir * 32 + h];
        const float a0 = Ah * d0, a1 = Ah * d1; float s = a0 + a1;
#pragma unroll
        for (int o = 1; o < 64; o <<= 1) { const float t = __shfl_up(s, o); if (lane >= o) s += t; }
        const float tot = __shfl(s, 63);
        float c0, c1;
        if (dir == 0) { c1 = s; c0 = s - a1; } else { c0 = tot - s + a0 + a1; c1 = tot - s + a1; }
        dtv[2 * lane] = d0; dtv[2 * lane + 1] = d1; cum[2 * lane] = c0; cum[2 * lane + 1] = c1;
        float* Eg = (float*)(rec + dir * 512); unsigned* Wg = (unsigned*)(rec + 1024 + dir * 256);
        *(float2*)(Eg + 2 * lane) = make_float2(__expf(c0), __expf(c1));
        Wg[lane] = pk2(__expf(tot - c0) * d0, __expf(tot - c1) * d1);
    }
    __syncthreads();
    {
        const int hl = wave >> 1, h = g * 8 + hf * 4 + hl;
        LAS float* dtf = scl + hl * 512, *dtb = dtf + 128, *af = dtf + 256, *rbv = dtf + 384;
        LAS bf16* XT = XTl + hl * (64 * RS);
        const float Dh = A.in[I_OD][h];
#pragma unroll 1
        for (int li = 0; li < 2; ++li) {
            const int lt = 2 * (wave & 1) + li, l = 32 * lt + l31;
            const float myaf = af[l], myrb = rbv[l];
            f32x16 Y0, Y1;
#pragma unroll
            for (int r = 0; r < 16; ++r) { Y0[r] = 0.f; Y1[r] = 0.f; }
#pragma unroll 1
            for (int st = 0; st < 4; ++st) {
                f32x16 cb;
#pragma unroll
                for (int r = 0; r < 16; ++r) cb[r] = 0.f;
#pragma unroll
                for (int ks = 0; ks < 8; ++ks) { const bf16x8 cf = *(const LAS bf16x8*)(Cn + l * RS + 16 * ks + 8 * hh);
                    const bf16x8 bfr = *(const LAS bf16x8*)(Bn + (32 * st + l31) * RS + 16 * ks + 8 * hh);
                    cb = __builtin_amdgcn_mfma_f32_32x32x16_bf16(bfr, cf, cb, 0, 0, 0); }
#pragma unroll
                for (int r4 = 0; r4 < 4; ++r4) { const int s0 = 32 * st + 8 * r4 + 4 * hh;
                    const f32x4 afs = *(const LAS f32x4*)(af + s0), rbs = *(const LAS f32x4*)(rbv + s0), dfs = *(const LAS f32x4*)(dtf + s0), dbs = *(const LAS f32x4*)(dtb + s0);
#pragma unroll
                    for (int j = 0; j < 4; ++j) { const int s = s0 + j;
                        const float wgt = (s < l) ? __expf(myaf - afs[j]) * dfs[j] : ((s > l) ? __expf(myrb - rbs[j]) * dbs[j] : (dfs[j] + dbs[j]));
                        cb[4 * r4 + j] *= wgt; } }
#pragma unroll
                for (int s2 = 0; s2 < 2; ++s2) { const int kb = 32 * st + 16 * s2 + 4 * hh; const bf16x8 mf = pack8(cb, s2);
                    { const u32x2 lo = *(const LAS u32x2*)(XT + l31 * RS + kb), hi = *(const LAS u32x2*)(XT + l31 * RS + kb + 8); const u32x4 xw = (u32x4){lo.x, lo.y, hi.x, hi.y};
                      Y0 = __builtin_amdgcn_mfma_f32_32x32x16_bf16(__builtin_bit_cast(bf16x8, xw), mf, Y0, 0, 0, 0); }
                    { const u32x2 lo = *(const LAS u32x2*)(XT + (32 + l31) * RS + kb), hi = *(const LAS u32x2*)(XT + (32 + l31) * RS + kb + 8); const u32x4 xw = (u32x4){lo.x, lo.y, hi.x, hi.y};
                      Y1 = __builtin_amdgcn_mfma_f32_32x32x16_bf16(__builtin_bit_cast(bf16x8, xw), mf, Y1, 0, 0, 0); } }
            }
            bf16* yrow = YM + (size_t)(b * SEQ + c * 128 + l) * DI + h * 64;
#pragma unroll
            for (int q4 = 0; q4 < 4; ++q4) { const int p0 = 8 * q4 + 4 * hh;
                float x0[4], x1[4];
#pragma unroll
                for (int j = 0; j < 4; ++j) { x0[j] = bf1(XT[(p0 + j) * RS + l]); x1[j] = bf1(XT[(32 + p0 + j) * RS + l]); }
                u32x2 w0, w1;
                w0.x = pk2(Y0[4 * q4] + Dh * x0[0], Y0[4 * q4 + 1] + Dh * x0[1]); w0.y = pk2(Y0[4 * q4 + 2] + Dh * x0[2], Y0[4 * q4 + 3] + Dh * x0[3]);
                w1.x = pk2(Y1[4 * q4] + Dh * x1[0], Y1[4 * q4 + 1] + Dh * x1[1]); w1.y = pk2(Y1[4 * q4 + 2] + Dh * x1[2], Y1[4 * q4 + 3] + Dh * x1[3]);
                *(u32x2*)(yrow + p0) = w0; *(u32x2*)(yrow + 32 + p0) = w1; }
        }
    }
}

__device__ __forceinline__ void ssd_seq_unit(const Frame& F, const Args& A, int b, int h) {
    const int tid = F.tid, lane = F.lane, wave = F.wave, l31 = lane & 31, hh = lane >> 5;
    LAS bf16* BT = (LAS bf16*)(F.lds + SQ_BT); LAS bf16* XT = (LAS bf16*)(F.lds + SQ_XT); LAS bf16* St = (LAS bf16*)(F.lds + SQ_ST);
    LAS float* El = (LAS float*)(F.lds + SQ_E); LAS float* Wl = (LAS float*)(F.lds + SQ_W);
    const bf16* XTg = (const bf16*)(F.ws + WS_XT); const bf16* BTg = (const bf16*)(F.ws + WS_BT); const bf16* CNg = (const bf16*)(F.ws + WS_CN);
    const unsigned char* SCg = F.ws + WS_SC;
    bf16* YM = (bf16*)(F.ws + WS_YM);
    const int g = h >> 3;
    const int lt = wave & 3, pt = wave >> 2;
    const int pt2 = wave & 1, nt = wave >> 1;
    for (int dir = 0; dir < 2; ++dir) {
        u32x4 pb[4], px[2], pc[8]; u32x2 ymn[4]; float pe = 0.f; unsigned pw = 0u;
#define SSD_PREFETCH(cc) do { const size_t rg_ = (size_t)((b * 16 + (cc)) * 4 + g), rh_ = (size_t)((b * 16 + (cc)) * 32 + h); \
        _Pragma("unroll") for (int i_ = 0; i_ < 4; ++i_) pb[i_] = *(const u32x4*)(BTg + rg_ * 16384 + (size_t)(tid + 512 * i_) * 8); \
        _Pragma("unroll") for (int i_ = 0; i_ < 2; ++i_) px[i_] = *(const u32x4*)(XTg + rh_ * 8192 + (size_t)(tid + 512 * i_) * 8); \
        _Pragma("unroll") for (int k_ = 0; k_ < 8; ++k_) pc[k_] = *(const u32x4*)(CNg + rg_ * 16384 + (32 * lt + l31) * 128 + 16 * k_ + 8 * hh); \
        if (tid < 128) { const unsigned char* rec_ = SCg + rh_ * SC_REC; pe = *(const float*)(rec_ + dir * 512 + tid * 4); pw = (unsigned)*(const bf16*)(rec_ + 1024 + dir * 256 + tid * 2); } \
        { const bf16* yr_ = YM + (size_t)(b * SEQ + (cc) * 128 + 32 * lt + l31) * DI + h * 64 + 32 * pt; \
        _Pragma("unroll") for (int q_ = 0; q_ < 4; ++q_) ymn[q_] = *(const u32x2*)(yr_ + 8 * q_ + 4 * hh); } } while (0)
#define SSD_COMMIT() do { \
        _Pragma("unroll") for (int i_ = 0; i_ < 4; ++i_) { const int q_ = tid + 512 * i_; *(LAS u32x4*)(BT + (q_ >> 4) * RS + (q_ & 15) * 8) = pb[i_]; } \
        _Pragma("unroll") for (int i_ = 0; i_ < 2; ++i_) { const int q_ = tid + 512 * i_; *(LAS u32x4*)(XT + (q_ >> 4) * RS + (q_ & 15) * 8) = px[i_]; } \
        if (tid < 128) { El[tid] = pe; Wl[tid] = __uint_as_float(pw << 16); } } while (0)
        __syncthreads();
        SSD_PREFETCH(dir ? 15 : 0);
        for (int i = tid; i < 64 * RS / 2; i += 512) ((LAS unsigned*)St)[i] = 0u;
        SSD_COMMIT();
        f32x16 stacc;
#pragma unroll
        for (int r = 0; r < 16; ++r) stacc[r] = 0.f;
        for (int step = 0; step < 16; ++step) {
            const int c = dir ? 15 - step : step;
            u32x4 cc8[8]; u32x2 ym[4];
#pragma unroll
            for (int k = 0; k < 8; ++k) cc8[k] = pc[k];
#pragma unroll
            for (int q4 = 0; q4 < 4; ++q4) ym[q4] = ymn[q4];
            __syncthreads();
            if (step < 15) SSD_PREFETCH(dir ? 14 - step : step + 1);
            bf16* yrow = YM + (size_t)(b * SEQ + c * 128 + 32 * lt + l31) * DI + h * 64 + 32 * pt;
            f32x16 Yo;
#pragma unroll
            for (int r = 0; r < 16; ++r) Yo[r] = 0.f;
#pragma unroll
            for (int ks = 0; ks < 8; ++ks) { const bf16x8 sf = *(const LAS bf16x8*)(St + (32 * pt + l31) * RS + 16 * ks + 8 * hh);
                Yo = __builtin_amdgcn_mfma_f32_32x32x16_bf16(sf, __builtin_bit_cast(bf16x8, cc8[ks]), Yo, 0, 0, 0); }
            const float e_l = El[32 * lt + l31];
#pragma unroll
            for (int q4 = 0; q4 < 4; ++q4) { u32x2 w;
                w.x = pk2(bflo(ym[q4].x) + e_l * Yo[4 * q4], bfhi(ym[q4].x) + e_l * Yo[4 * q4 + 1]); w.y = pk2(bflo(ym[q4].y) + e_l * Yo[4 * q4 + 2], bfhi(ym[q4].y) + e_l * Yo[4 * q4 + 3]);
                *(u32x2*)(yrow + 8 * q4 + 4 * hh) = w; }
            const float decay = dir ? El[0] : El[127];
#pragma unroll
            for (int r = 0; r < 16; ++r) stacc[r] *= decay;
            const int pp = 32 * pt2 + l31, nn = 32 * nt + l31;
#pragma unroll
            for (int ks = 0; ks < 8; ++ks) { const int l0 = 16 * ks + 8 * hh;
                const u32x4 xr = *(const LAS u32x4*)(XT + pp * RS + l0); const f32x4 w0 = *(const LAS f32x4*)(Wl + l0), w1 = *(const LAS f32x4*)(Wl + l0 + 4);
                u32x4 xs; xs.x = pk2(bflo(xr.x) * w0[0], bfhi(xr.x) * w0[1]); xs.y = pk2(bflo(xr.y) * w0[2], bfhi(xr.y) * w0[3]);
                xs.z = pk2(bflo(xr.z) * w1[0], bfhi(xr.z) * w1[1]); xs.w = pk2(bflo(xr.w) * w1[2], bfhi(xr.w) * w1[3]);
                const bf16x8 bt = *(const LAS bf16x8*)(BT + nn * RS + l0);
                stacc = __builtin_amdgcn_mfma_f32_32x32x16_bf16(__builtin_bit_cast(bf16x8, xs), bt, stacc, 0, 0, 0); }
            __syncthreads();
            if (step < 15) {
                SSD_COMMIT();
#pragma unroll
                for (int r = 0; r < 16; ++r) { const int prow = 32 * pt2 + (r & 3) + 8 * (r >> 2) + 4 * hh; St[prow * RS + nn] = (bf16)(pk2(stacc[r], 0.f) & 0xffffu); }
            }
        }
#undef SSD_PREFETCH
#undef SSD_COMMIT
    }
}

__device__ __forceinline__ void gnorm_phase(const Frame& F, const Args& A) {
    const int lane = F.lane;
    const bf16* YM = (const bf16*)(F.ws + WS_YM); const bf16* Z = (const bf16*)(F.ws + WS_Z); bf16* YN = (bf16*)(F.ws + WS_YN);
    const float* gw = A.in[I_OGN];
    const int gwv = F.vcu * 8 + F.wave, NGW = F.G * 8;
    for (int row = gwv; row < T; row += NGW) {
        float v[32]; float ss = 0.f;
#pragma unroll
        for (int j = 0; j < 4; ++j) { const int c = 8 * lane + 512 * j;
            const u32x4 y4 = *(const u32x4*)(YM + (size_t)row * DI + c), z4 = *(const u32x4*)(Z + (size_t)row * DI + c);
            const unsigned yw[4] = {y4.x, y4.y, y4.z, y4.w}, zw[4] = {z4.x, z4.y, z4.z, z4.w};
#pragma unroll
            for (int e = 0; e < 4; ++e) { const float a = bflo(yw[e]) * siluf(bflo(zw[e])), c2 = bfhi(yw[e]) * siluf(bfhi(zw[e])); v[j * 8 + 2 * e] = a; v[j * 8 + 2 * e + 1] = c2; ss += a * a + c2 * c2; } }
        const float rstd = 1.0f / sqrtf(wave_sum(ss) * (1.0f / DI) + EPS);
#pragma unroll
        for (int j = 0; j < 4; ++j) { const int c = 8 * lane + 512 * j; const f32x4 g0 = *(const f32x4*)(gw + c), g1 = *(const f32x4*)(gw + c + 4);
            u32x4 o; o.x = pk2(v[j * 8] * rstd * g0[0], v[j * 8 + 1] * rstd * g0[1]); o.y = pk2(v[j * 8 + 2] * rstd * g0[2], v[j * 8 + 3] * rstd * g0[3]);
            o.z = pk2(v[j * 8 + 4] * rstd * g1[0], v[j * 8 + 5] * rstd * g1[1]); o.w = pk2(v[j * 8 + 6] * rstd * g1[2], v[j * 8 + 7] * rstd * g1[3]);
            *(u32x4*)(YN + (size_t)row * DI + c) = o; }
    }
}

__device__ __forceinline__ int moe_tables(const Frame& F, LAS int* pexp  , LAS int* eoff  , LAS int* ecnt  ) {
    const unsigned* gcnt = (const unsigned*)(F.ws + WS_CTL) + CW_GCNT;
    __syncthreads();
    if (F.tid == 0) { int off = 0; for (int e = 0; e < 8; ++e) { const int cnt = (int)__hip_atomic_load(gcnt + e, __ATOMIC_RELAXED, __HIP_MEMORY_SCOPE_AGENT); ecnt[e] = cnt; eoff[e] = off; const int np = (cnt + 255) >> 8;
            for (int p = 0; p < np; ++p) pexp[(off >> 8) + p] = e; off += np << 8; } eoff[8] = off; }
    __syncthreads();
    return eoff[8] >> 8;
}
__device__ __forceinline__ void gather_phase(const Frame& F) {
    LAS int* pexp = (LAS int*)F.lds; LAS int* eoff = pexp + MAXPAN; LAS int* ecnt = eoff + 9;
    const int npan = moe_tables(F, pexp, eoff, ecnt);
    const int* toke = (const int*)(F.ws + WS_ROUTE + RT_TOKE); const int* tokp = (const int*)(F.ws + WS_ROUTE + RT_TOKP); int* rowtok = (int*)(F.ws + WS_ROUTE + RT_ROWTOK);
    const bf16* XN = (const bf16*)(F.ws + WS_XN); bf16* AP = (bf16*)(F.ws + WS_AP);
    const int gwv = F.vcu * 8 + F.wave, NGW = F.G * 8, lane = F.lane;
    for (int i = gwv; i < T * 2; i += NGW) {
        const int e = toke[i], row = eoff[e] + tokp[i], tok = i >> 1;
        if (lane == 0) rowtok[row] = i;
        const u32x4* src = (const u32x4*)((const unsigned char*)XN + (size_t)tok * D); u32x4* dst = (u32x4*)((unsigned char*)AP + (size_t)row * D);
        dst[lane] = src[lane];
    }
    const int npad_total = npan * 256;
    for (int row = gwv; row < npad_total; row += NGW) {
        const int e = pexp[row >> 8];
        if (row >= eoff[e] + ecnt[e]) { if (lane == 0) rowtok[row] = -1;
            u32x4* dst = (u32x4*)((unsigned char*)AP + (size_t)row * D); dst[lane] = (u32x4){0u, 0u, 0u, 0u}; }
    }
}

__device__ __forceinline__ void combine_phase(const Frame& F, const Args& A, float* out) {
    const int lane = F.lane;
    const bf16* YS = (const bf16*)(F.ws + WS_YS); const float* tokw = (const float*)(F.ws + WS_ROUTE + RT_TOKW);
    const float* g2 = (const float*)(F.ws + WS_MOD) + 49152 + 5120;
    const int gwv = F.vcu * 8 + F.wave, NGW = F.G * 8;
    for (int tok = gwv; tok < T; tok += NGW) {
        const float w0 = tokw[2 * tok], w1 = tokw[2 * tok + 1]; const int b = tok / SEQ;
        const bf16* y0 = YS + (size_t)(2 * tok) * D, *y1 = y0 + D; float* orow = out + (size_t)tok * D; const float* gr = g2 + b * 6144;
#pragma unroll
        for (int j = 0; j < 2; ++j) { const int c = 8 * lane + 512 * j;
            const u32x4 a4 = *(const u32x4*)(y0 + c), b4 = *(const u32x4*)(y1 + c);
            const f32x4 g0 = *(const f32x4*)(gr + c), g1 = *(const f32x4*)(gr + c + 4); f32x4 o0 = *(const f32x4*)(orow + c), o1 = *(const f32x4*)(orow + c + 4);
            o0[0] += g0[0] * (w0 * bflo(a4.x) + w1 * bflo(b4.x)); o0[1] += g0[1] * (w0 * bfhi(a4.x) + w1 * bfhi(b4.x));
            o0[2] += g0[2] * (w0 * bflo(a4.y) + w1 * bflo(b4.y)); o0[3] += g0[3] * (w0 * bfhi(a4.y) + w1 * bfhi(b4.y));
            o1[0] += g1[0] * (w0 * bflo(a4.z) + w1 * bflo(b4.z)); o1[1] += g1[1] * (w0 * bfhi(a4.z) + w1 * bfhi(b4.z));
            o1[2] += g1[2] * (w0 * bflo(a4.w) + w1 * bflo(b4.w)); o1[3] += g1[3] * (w0 * bfhi(a4.w) + w1 * bfhi(b4.w));
            *(f32x4*)(orow + c) = o0; *(f32x4*)(orow + c + 4) = o1; }
    }
}

constexpr int NPHASE = 19;
__global__ void __launch_bounds__(512, 2) hybrid_fwd(Args args) {
    extern __shared__ __attribute__((aligned(16))) unsigned char lds_raw[];
    Frame F0;
    F0.lds = (LAS unsigned char*)lds_raw; F0.ws = args.ws;
    F0.tid = threadIdx.x; F0.lane = F0.tid & 63; F0.wave = __builtin_amdgcn_readfirstlane(F0.tid >> 6);
    F0.G = gridDim.x; { const int bx = blockIdx.x; F0.vcu = (F0.G % 8 == 0) ? (bx % 8) * (F0.G / 8) + bx / 8 : bx; }
    volatile LAS unsigned* MISC = (volatile LAS unsigned*)(F0.lds + MISC_OFF);
    if (F0.tid < 32) MISC[F0.tid] = 0u;
    __syncthreads();
    unsigned* ctl = (unsigned*)(args.ws + WS_CTL);
    XcdBarrier bar; bar.bar = ctl + CW_BAR; bar.x = 0; bar.st = nullptr;
#if MK_N_LAUNCHES == 1
    bar = xcd_barrier_post(ctl + CW_BAR, MISC + 8);
#define GRID_BAR() xcd_barrier(bar)
#else
#define GRID_BAR() do { } while (0)
#endif
    const int lo = args.ph_lo, hi = args.ph_hi;
#ifndef PHASE_MASK
#define PHASE_MASK 0x7ffff
#endif
#define IN(k) ((((PHASE_MASK) >> (k)) & 1) && lo <= (k) && (k) < hi)
#define SEAM(k) do { if (IN(k) && IN((k) + 1)) GRID_BAR(); } while (0)
#ifndef REP_PHASE
#define REP_PHASE -1
#endif
#define PHASE_BODY(...) { unsigned char* ws = args.ws; asm volatile("" : "+s"(ws)); Frame F = F0; F.ws = ws; const float* MOD = (const float*)(ws + WS_MOD); (void)MOD; __VA_ARGS__ }
#define PHASE(k, ...) do { if (IN(k)) PHASE_BODY(__VA_ARGS__) if ((REP_PHASE) == (k) && IN(k)) { __syncthreads(); PHASE_BODY(__VA_ARGS__) } } while (0)
    const int c = (int)blockIdx.x;

    PHASE(0,  p0_prologue(F, args); ); SEAM(0);
    PHASE(1,  modulate_phase<0>(F, args, args.in[I_X], args.in[I_EN1], 0, 0); ); SEAM(1);
    PHASE(2,
        { SchedPlain S{(const char*)(ws + WS_WU), (const char*)(ws + WS_XN), 4, 64, F.G, c, (size_t)256 * 1024 * 2}; EpiUT E{(bf16*)(ws + WS_UT)};
          pg8::gemm_phase(F.lds, 2048, S, E); }
        { SchedPlain S{(const char*)(ws + WS_XN), (const char*)(ws + WS_WQKV), 64, 3, F.G, c, (size_t)256 * 1024 * 2}; EpiBf16 E{(bf16*)(ws + WS_QKV), QKVW};
          pg8::gemm_phase(F.lds, 2048, S, E); }
    ); SEAM(2);
    PHASE(3,
        const int sub = F.vcu & 31, x = F.vcu >> 5;
        if (sub < 16) { SchedFourier S{(const char*)(ws + WS_FDFT), (const char*)(ws + WS_UT), x * 16 + sub}; EpiBf16 E{(bf16*)(ws + WS_Y0), D};
            pg8::gemm_phase(F.lds, 8192, S, E); }
        else { const int a = sub - 16; attn_unit(F, args, x, a, 0); attn_unit(F, args, x, a, 1); }
    ); SEAM(3);
    PHASE(4,  SchedPlain S{(const char*)(ws + WS_Y0), (const char*)(ws + WS_WO0), 64, 4, F.G, c, (size_t)256 * 1024 * 2}; EpiRes E{args.in[I_X], args.out, MOD + 2048};
        pg8::gemm_phase(F.lds, 2048, S, E); ); SEAM(4);
    PHASE(5,  modulate_phase<1>(F, args, args.out, args.in[I_EN2], 0, 1); ); SEAM(5);
    PHASE(6,  SchedPlain S{(const char*)(ws + WS_XN), (const char*)(ws + WS_WF13), 64, 22, F.G, c, (size_t)256 * 1024 * 2}; EpiSwiglu E{(bf16*)(ws + WS_H0), DFF};
        pg8::gemm_phase(F.lds, 2048, S, E); ); SEAM(6);
    PHASE(7,  SchedPlain S{(const char*)(ws + WS_H0), (const char*)(ws + WS_WF2), 64, 4, F.G, c, (size_t)256 * DFF * 2}; EpiRes E{args.out, args.out, MOD + 5120};
        pg8::gemm_phase(F.lds, DFF * 2, S, E); ); SEAM(7);
    PHASE(8,  modulate_phase<1>(F, args, args.out, args.in[I_ON1], 1, 0); ); SEAM(8);
    PHASE(9,  { SchedPlain S{(const char*)(ws + WS_XN), (const char*)(ws + WS_WSIN), 64, 20, F.G, c, (size_t)256 * 1024 * 2}; EpiSsmIn E{(bf16*)(ws + WS_Z), (bf16*)(ws + WS_XBC)};
        pg8::gemm_phase(F.lds, 2048, S, E); } dt_phase(F, args); ); SEAM(9);
    PHASE(10,  for (int u = F.vcu; u < 1024; u += F.G) ssd_local_unit(F, args, u >> 7, (u >> 3) & 15, (u >> 1) & 3, u & 1); ); SEAM(10);
    PHASE(11,  for (int u = F.vcu; u < NBATCH * NHEAD_SSM; u += F.G) ssd_seq_unit(F, args, u >> 5, u & 31); ); SEAM(11);
    PHASE(12,  gnorm_phase(F, args); ); SEAM(12);
    PHASE(13,  SchedPlain S{(const char*)(ws + WS_YN), (const char*)(ws + WS_WSOUT), 64, 4, F.G, c, (size_t)256 * DI * 2}; EpiRes E{args.out, args.out, MOD + 49152 + 2048};
        pg8::gemm_phase(F.lds, DI * 2, S, E); ); SEAM(13);
    PHASE(14,  modulate_phase<2>(F, args, args.out, args.in[I_ON2], 1, 1); ); SEAM(14);
    PHASE(15,  gather_phase(F); ); SEAM(15);
    PHASE(16,  LAS int* pexp = (LAS int*)(F.lds + 131072 + 4096); LAS int* eoff = pexp + MAXPAN; LAS int* ecnt = eoff + 9;
        const int npan = moe_tables(F, pexp, eoff, ecnt);
        SchedMoe S{(const char*)(ws + WS_AP), (const char*)(ws + WS_WM13), pexp, npan, 28, F.G, c, (size_t)256 * 1024, (size_t)256 * 1024, 28}; EpiSwiglu8 E{(unsigned char*)(ws + WS_HP), DFE};
        pg8::gemm_phase(F.lds, 1024, S, E); ); SEAM(16);
    PHASE(17,  LAS int* pexp = (LAS int*)(F.lds + 131072 + 4096); LAS int* eoff = pexp + MAXPAN; LAS int* ecnt = eoff + 9;
        const int npan = moe_tables(F, pexp, eoff, ecnt);
        SchedMoe S{(const char*)(ws + WS_HP), (const char*)(ws + WS_WM2), pexp, npan, 4, F.G, c, (size_t)256 * DFE, (size_t)256 * DFE, 4};
        EpiMoeSlot E{(bf16*)(ws + WS_YS), (const int*)(ws + WS_ROUTE + RT_ROWTOK)};
        pg8::gemm_phase(F.lds, DFE, S, E);     ); SEAM(17);
    PHASE(18,  combine_phase(F, args, args.out); );
#undef IN
#undef SEAM
}

extern "C" void kernel_launch(void* const* d_in, const int* in_sizes, int n_in, void* d_out, int out_size, void* d_ws, size_t ws_size, hipStream_t stream) {
    static int grid = 0;
    if (grid == 0) {
        if (n_in != 34 || ws_size < WS_END) { grid = -1; return; }
        int dev = 0, cus = 0;
        if (hipGetDevice(&dev) != hipSuccess || hipDeviceGetAttribute(&cus, hipDeviceAttributeMultiprocessorCount, dev) != hipSuccess) { grid = -1; return; }
        if (hipFuncSetAttribute((const void*)hybrid_fwd, hipFuncAttributeMaxDynamicSharedMemorySize, LDS_BYTES) != hipSuccess) { grid = -1; return; }
        int per_cu = 0;
        (void)hipOccupancyMaxActiveBlocksPerMultiprocessor(&per_cu, (const void*)hybrid_fwd, 512, LDS_BYTES);
        (void)hipGetLastError();
        grid = cus;
    }
    if (grid < 0) return;
    (void)hipMemsetAsync((char*)d_ws + WS_CTL, 0, CTL_ZERO_BYTES, stream);
    Args a{};
    for (int i = 0; i < 34; ++i) a.in[i] = (const float*)d_in[i];
    a.out = (float*)d_out; a.ws = (unsigned char*)d_ws;
#if MK_N_LAUNCHES == 1
    a.ph_lo = 0; a.ph_hi = NPHASE;
    hipLaunchKernelGGL(hybrid_fwd, dim3(grid), dim3(512), LDS_BYTES, stream, a);
#else
    for (int p = 0; p < NPHASE; ++p) { a.ph_lo = p; a.ph_hi = p + 1; hipLaunchKernelGGL(hybrid_fwd, dim3(grid), dim3(512), LDS_BYTES, stream, a); }
#endif
}
```

```cpp
#include <hip/hip_runtime.h>
#include <stdint.h>

#ifndef BG2
#define BG2 6
#endif
#ifndef BG3
#define BG3 16
#endif
#ifndef BG6
#define BG6 8
#endif
#ifndef MK_N_LAUNCHES
#define MK_N_LAUNCHES 1
#endif

#define LAS __attribute__((address_space(3)))
#define GAS __attribute__((address_space(1)))
typedef unsigned short bf16;
typedef short bf16x8 __attribute__((ext_vector_type(8)));
typedef float f32x4 __attribute__((ext_vector_type(4)));
typedef float f32x16 __attribute__((ext_vector_type(16)));
typedef unsigned u32x4 __attribute__((ext_vector_type(4)));
typedef unsigned u32x2 __attribute__((ext_vector_type(2)));

constexpr int D = 1024, NBATCH = 8, SEQ = 2048, T = NBATCH * SEQ;
constexpr int DFF = 2816, DI = 2048, CDIM = 3072, NHEAD_SSM = 32, NEXP = 8, DFE = 3584;
constexpr int QKVW = 768;
constexpr int MAXPAN = 136;
constexpr float EPS = 1e-6f;

constexpr size_t MiB = 1u << 20;
constexpr size_t WS_CTL = 0, CTL_ZERO_BYTES = 1 * MiB;
constexpr size_t WS_MODP = 1 * MiB;
constexpr size_t WS_MOD = 7 * MiB;
constexpr size_t WS_ROUTE = 7 * MiB + 512 * 1024;
constexpr size_t WS_WM13 = 9 * MiB;
constexpr size_t WS_WM2 = 121 * MiB;
constexpr size_t WS_WU = 192 * MiB;
constexpr size_t WS_WQKV = 194 * MiB;
constexpr size_t WS_WO0 = 196 * MiB;
constexpr size_t WS_WF13 = 198 * MiB;
constexpr size_t WS_WF2 = 209 * MiB;
constexpr size_t WS_WSIN = 181 * MiB;
constexpr size_t WS_WSOUT = 177 * MiB;
constexpr size_t WS_FDFT = 215 * MiB;
constexpr size_t WS_ACT = 231 * MiB;
constexpr size_t WS_XN = WS_ACT;
constexpr size_t WS_UT = WS_ACT + 32 * MiB;
constexpr size_t WS_QKV = WS_ACT + 64 * MiB;
constexpr size_t WS_Y0 = WS_ACT + 88 * MiB;
constexpr size_t WS_H0 = WS_ACT + 120 * MiB;
constexpr size_t WS_Z = WS_ACT + 32 * MiB;
constexpr size_t WS_XBC = WS_ACT + 96 * MiB;
constexpr size_t WS_DT = WS_ACT + 192 * MiB;
constexpr size_t WS_YM = WS_ACT + 196 * MiB;
constexpr size_t WS_YN = WS_XBC;
constexpr size_t WS_HP = 177 * MiB;
constexpr size_t WS_AP = 415 * MiB;
constexpr size_t WS_XT = 181 * MiB;
constexpr size_t WS_BT = 245 * MiB;
constexpr size_t WS_CN = WS_ACT + 260 * MiB;
constexpr size_t WS_SC = 1 * MiB;
constexpr size_t WS_YS = WS_WM13;
constexpr size_t WS_END = 507 * MiB;
constexpr size_t RT_TOKE = 0;
constexpr size_t RT_TOKP = 131072;
constexpr size_t RT_TOKW = 262144;
constexpr size_t RT_ROWTOK = 393216;
constexpr size_t RT_ROWW = 393216 + 139264;
constexpr int CW_BAR = 4096;
constexpr int CW_GCNT = 16384;
constexpr int CW_CONV = 16384 + 64;

constexpr int LDS_BYTES = 163840 - 512;
constexpr int MISC_OFF = 160000;

typedef float f32x2_t __attribute__((ext_vector_type(2)));
typedef __bf16 bf16x2_t __attribute__((ext_vector_type(2)));
__device__ __forceinline__ unsigned pk2(float lo, float hi) { const f32x2_t v = {lo, hi}; const bf16x2_t b = __builtin_convertvector(v, bf16x2_t); return __builtin_bit_cast(unsigned, b); }
__device__ __forceinline__ unsigned pk2v(float lo, float hi) { unsigned r; asm volatile("v_cvt_pk_bf16_f32 %0, %1, %2" : "=v"(r) : "v"(lo), "v"(hi)); return r; }
__device__ __forceinline__ float bflo(unsigned u) { return __uint_as_float(u << 16); }
__device__ __forceinline__ float bfhi(unsigned u) { return __uint_as_float(u & 0xffff0000u); }
__device__ __forceinline__ float bf1(bf16 b) { return __uint_as_float(((unsigned)b) << 16); }
__device__ __forceinline__ float siluf(float x) { return x / (1.0f + __expf(-x)); }
__device__ __forceinline__ float wave_sum(float v) {
#pragma unroll
    for (int o = 1; o < 64; o <<= 1) v += __shfl_xor(v, o);
    return v;
}
__device__ __forceinline__ unsigned pk4_fp8(float a, float b, float c, float d) { int w = 0; w = __builtin_amdgcn_cvt_pk_fp8_f32(a, b, w, false); w = __builtin_amdgcn_cvt_pk_fp8_f32(c, d, w, true); return (unsigned)w; }
#define LDS_WAIT() asm volatile("s_waitcnt lgkmcnt(0)" ::: "memory")
#define VM_WAIT() asm volatile("s_waitcnt vmcnt(0)" ::: "memory")

namespace pg8 {
typedef int v4i_t __attribute__((ext_vector_type(4)));
typedef int v8i_t __attribute__((ext_vector_type(8)));
constexpr int BM = 256, BK = 64, HALF = 128, HTB = HALF * BK * 2, STAGE_BYTES = 8 * HTB, NXCD = 8, WGM = 8;
__host__ __device__ __forceinline__ int lds_byte(int r, int c) { const int st = (r >> 4) * 2 + (c >> 5), rr = r & 15, cc = c & 31, ob = rr * 64 + cc * 2; return st * 1024 + (ob ^ (((ob >> 9) & 1) << 5)); }
__host__ __device__ __forceinline__ void stage_rc(int b, int& R, int& C) { const int st = b / 1024, sb = b % 1024, swz = sb ^ (((sb >> 9) & 1) << 5); R = (st >> 1) * 16 + swz / 64; C = (st & 1) * 32 + (swz % 64) / 2; }
__host__ __device__ __forceinline__ int perm32(int rho) { const int n = rho >> 4, i = rho & 15; return 8 * (i >> 2) + 4 * n + (i & 3); }

struct Unit { const char* a; const char* b; int pm, pn; };

__device__ __forceinline__ bool tile_order(int i, int G, int c, int nM, int nN, int& pm, int& pn) {
    const int nwg = nM * nN; const long L = (long)i * G + c; if (L >= nwg) return false;
    int wgid = (int)L; { const int q = nwg / NXCD, r = nwg % NXCD, xcd = wgid % NXCD, off = wgid / NXCD; wgid = (xcd < r ? xcd * (q + 1) : r * (q + 1) + (xcd - r) * q) + off; }
    const int nig = WGM * nN, gid = wgid / nig, fm = gid * WGM, gsz = (nM - fm) < WGM ? (nM - fm) : WGM;
    pm = fm + ((wgid % nig) % gsz); pn = (wgid % nig) / gsz; return true;
}

template <class Epi, class Sched>
__device__ __forceinline__ void gemm_phase(LAS unsigned char* lds, const int RB, const Sched& S, const Epi& E) {
    const int tid = threadIdx.x, wid = __builtin_amdgcn_readfirstlane(tid >> 6), lane = tid & 63, wr = wid >> 2, wc = wid & 3, fr = lane & 15, fq = lane >> 4;
    const int nt = RB / 128;
    unsigned voffA[2], voffB[2];
#pragma unroll
    for (int i = 0; i < 2; ++i) { int R, C; stage_rc(tid * 16 + i * 8192, R, C); const int Rb = Epi::PERM ? ((R & ~31) + perm32(R & 31)) : R;
        voffA[i] = (unsigned)(R * RB + C * 2); voffB[i] = (unsigned)(Rb * RB + C * 2); }
    const size_t kstep = (size_t)(BK * 2);
    const size_t hstep = (size_t)HALF * RB;
    const unsigned ldsw = (unsigned)wid * 1024u;
    const int aoff = lds_byte(wr * 64 + fr, fq * 8), boff = lds_byte(wc * 32 + fr, fq * 8);
#define PG8_SA(b, h) (((b) * 2 + (h)) * HTB)
#define PG8_SB(b, h) ((4 + (b) * 2 + (h)) * HTB)
#define PG8_STAGE(bufoff, gbase, voff) do { _Pragma("unroll") for (int _i = 0; _i < 2; ++_i) \
        __builtin_amdgcn_global_load_lds((const unsigned*)((const char*)(gbase) + (voff)[_i]), (LAS unsigned*)(lds + (bufoff) + ldsw + _i * 8192), 16, 0, 0); } while (0)
#define PG8_LD8(addr) __builtin_shufflevector(*(const LAS v4i_t*)(addr), *(const LAS v4i_t*)((addr) + 1024), 0, 1, 2, 3, 4, 5, 6, 7)
#define PG8_LDA(dst, b, h) do { if constexpr (Epi::FP8) { _Pragma("unroll") for (int m = 0; m < 4; ++m) dst##8[m] = PG8_LD8(lds + PG8_SA(b, h) + aoff + m * 2048); } \
        else { _Pragma("unroll") for (int m = 0; m < 4; ++m) _Pragma("unroll") for (int k = 0; k < 2; ++k) dst[m][k] = *(const LAS bf16x8*)(lds + PG8_SA(b, h) + aoff + m * 2048 + k * 1024); } } while (0)
#define PG8_LDB(dst, b, h) do { if constexpr (Epi::FP8) { _Pragma("unroll") for (int n = 0; n < 2; ++n) dst##8[n] = PG8_LD8(lds + PG8_SB(b, h) + boff + n * 2048); } \
        else { _Pragma("unroll") for (int n = 0; n < 2; ++n) _Pragma("unroll") for (int k = 0; k < 2; ++k) dst[n][k] = *(const LAS bf16x8*)(lds + PG8_SB(b, h) + boff + n * 2048 + k * 1024); } } while (0)
#define PG8_MMA(ai, bj, At, Bt) do { __builtin_amdgcn_s_setprio(1); if constexpr (Epi::FP8) { _Pragma("unroll") for (int m = 0; m < 4; ++m) _Pragma("unroll") for (int n = 0; n < 2; ++n) \
            asm volatile("v_mfma_scale_f32_16x16x128_f8f6f4 %0, %1, %2, %0, %3, %3 op_sel_hi:[0,0,0]" : "+v"(acc[ai][bj][m][n]) : "v"(Bt##8[n]), "v"(At##8[m]), "v"(scl8)); } \
        else { _Pragma("unroll") for (int m = 0; m < 4; ++m) _Pragma("unroll") for (int n = 0; n < 2; ++n) _Pragma("unroll") for (int k = 0; k < 2; ++k) \
        acc[ai][bj][m][n] = __builtin_amdgcn_mfma_f32_16x16x32_bf16(Bt[n][k], At[m][k], acc[ai][bj][m][n], 0, 0, 0); } __builtin_amdgcn_s_setprio(0); } while (0)
#define PG8_WAIT_V(n) asm volatile("s_waitcnt vmcnt(" #n ")" ::: "memory")
#define PG8_WAIT_L(n) asm volatile("s_waitcnt lgkmcnt(" #n ")" ::: "memory")
#define PG8_BAR __builtin_amdgcn_s_barrier()
#define PG8_SCHED __builtin_amdgcn_sched_barrier(0)
    Unit cur, nxt; int ui = 0;
    if (!S.next(0, cur)) return;
    f32x4 acc[2][2][4][2];
#pragma unroll
    for (int a = 0; a < 2; ++a)
#pragma unroll
        for (int b = 0; b < 2; ++b)
#pragma unroll
            for (int m = 0; m < 4; ++m)
#pragma unroll
                for (int n = 0; n < 2; ++n) acc[a][b][m][n] = (f32x4){0.f, 0.f, 0.f, 0.f};
    bf16x8 At[4][2], B0[2][2], B1[2][2]; v8i_t At8[4], B08[2], B18[2]; const int scl8 = 0x7f7f7f7f;
    const char* cA = cur.a; const char* cB = cur.b;
    PG8_STAGE(PG8_SB(0, 0), cB, voffB); PG8_STAGE(PG8_SB(0, 1), cB + hstep, voffB); PG8_STAGE(PG8_SA(0, 0), cA, voffA); PG8_STAGE(PG8_SA(0, 1), cA + hstep, voffA);
    if (wr == 1) PG8_BAR;
    PG8_WAIT_V(2); PG8_BAR;
    PG8_STAGE(PG8_SB(1, 0), cB + kstep, voffB); PG8_STAGE(PG8_SA(1, 0), cA + kstep, voffA); PG8_STAGE(PG8_SB(1, 1), cB + hstep + kstep, voffB);
    PG8_WAIT_V(6); PG8_BAR;
    for (;;) {
        const bool has_next = S.next(ui + 1, nxt);
        const char* nA = has_next ? nxt.a : cA; const char* nB = has_next ? nxt.b : cB;
#pragma unroll 1
        for (int t = 0; t < nt; t += 2) {
            const bool last = (t == nt - 2);
            const char* a1 = cA + (size_t)(t + 1) * kstep;
            const char* a2 = last ? nA : cA + (size_t)(t + 2) * kstep; const char* b2 = last ? nB : cB + (size_t)(t + 2) * kstep;
            const char* a3 = a2 + kstep; const char* b3 = b2 + kstep;
            PG8_LDB(B0, 0, 0); PG8_LDB(B1, 0, 1); PG8_SCHED; PG8_LDA(At, 0, 0); PG8_STAGE(PG8_SA(1, 1), a1 + hstep, voffA);
            PG8_WAIT_V(8); PG8_WAIT_L(0); PG8_BAR; PG8_MMA(0, 0, At, B0); PG8_MMA(0, 1, At, B1); PG8_BAR; PG8_SCHED;
            PG8_LDA(At, 0, 1); PG8_STAGE(PG8_SB(0, 0), b2, voffB); PG8_STAGE(PG8_SB(0, 1), b2 + hstep, voffB); PG8_STAGE(PG8_SA(0, 0), a2, voffA);
            PG8_WAIT_V(8); PG8_WAIT_L(0); PG8_BAR; PG8_MMA(1, 0, At, B0); PG8_MMA(1, 1, At, B1); PG8_BAR; PG8_SCHED;
            PG8_LDB(B0, 1, 0); PG8_LDB(B1, 1, 1); PG8_SCHED; PG8_LDA(At, 1, 0); PG8_STAGE(PG8_SA(0, 1), a2 + hstep, voffA);
            PG8_WAIT_V(8); PG8_WAIT_L(0); PG8_BAR; PG8_MMA(0, 0, At, B0); PG8_MMA(0, 1, At, B1); PG8_BAR; PG8_SCHED;
            PG8_LDA(At, 1, 1); PG8_STAGE(PG8_SB(1, 0), b3, voffB); PG8_STAGE(PG8_SB(1, 1), b3 + hstep, voffB); PG8_STAGE(PG8_SA(1, 0), a3, voffA);
            PG8_WAIT_V(8); PG8_WAIT_L(0); PG8_BAR; PG8_MMA(1, 0, At, B0); PG8_MMA(1, 1, At, B1); PG8_BAR; PG8_SCHED;
        }
        if (wr == 0) PG8_BAR;
        if constexpr (Epi::FP8) asm volatile("s_nop 15\n\ts_nop 15\n\ts_nop 15\n\ts_nop 15\n\ts_nop 15" ::: "memory");
        E(acc, cur, wr, wc, fr, fq);
        if (!has_next) break;
#pragma unroll
        for (int a = 0; a < 2; ++a)
#pragma unroll
            for (int b = 0; b < 2; ++b)
#pragma unroll
                for (int m = 0; m < 4; ++m)
#pragma unroll
                    for (int n = 0; n < 2; ++n) acc[a][b][m][n] = (f32x4){0.f, 0.f, 0.f, 0.f};
        cur = nxt; cA = nA; cB = nB; ++ui;
        if (wr == 1) PG8_BAR;
    }
    PG8_WAIT_V(0);
    PG8_BAR;
#undef PG8_SA
#undef PG8_SB
#undef PG8_STAGE
#undef PG8_LDA
#undef PG8_LDB
#undef PG8_MMA
#undef PG8_WAIT_V
#undef PG8_WAIT_L
#undef PG8_BAR
#undef PG8_SCHED
}
}
using pg8::Unit;

#define XB_TMO      128
#define XB_XCNT(j)  (256  + 64 * (j))
#define XB_XSUB(j)  (1280 + 64 * (j))
#define XB_XGEN(j)  (2304 + 64 * (j))
#define XB_TOP      3328
#define XB_TOPGEN   3392
#define XCD_BAR_WORDS 3456
#define XB_SPIN_CAP (1u << 18)
__device__ __forceinline__ unsigned xb_ld(unsigned* p)              { return __hip_atomic_load(p, __ATOMIC_RELAXED, __HIP_MEMORY_SCOPE_AGENT); }
__device__ __forceinline__ unsigned xb_add(unsigned* p, unsigned v) { return __hip_atomic_fetch_add(p, v, __ATOMIC_RELAXED, __HIP_MEMORY_SCOPE_AGENT); }
__device__ __forceinline__ unsigned xb_xcc_id() { return (unsigned)__builtin_amdgcn_s_getreg((3 << 11) | 20) & 0xFu; }
#define XB_SPIN(cond, bar) do { unsigned _sp = 0; while (cond) { __builtin_amdgcn_s_sleep(1); \
    if ((++_sp & 255u) == 0u) { if (xb_ld(&(bar)[XB_TMO])) break; if (_sp > XB_SPIN_CAP) { atomicAdd(&(bar)[XB_TMO], 1u); break; } } } } while (0)
struct XcdBarrier { unsigned* bar; unsigned x; volatile LAS unsigned* st; };
__device__ __forceinline__ XcdBarrier xcd_barrier_post(unsigned* bar, volatile LAS unsigned* st) {
    XcdBarrier b; b.bar = bar; b.x = xb_xcc_id(); b.st = st;
    if (threadIdx.x == 0) (void)xb_add(&bar[XB_XCNT(b.x)], 1u);
    return b;
}
__device__ __forceinline__ void xcd_barrier_complete(unsigned* bar, unsigned x, unsigned& nloc, unsigned& nx) {
    const unsigned G = gridDim.x * gridDim.y * gridDim.z;
    unsigned sum, cnt, mine, sp = 0u;
    for (;;) {
        sum = 0u; cnt = 0u; mine = 0u;
#pragma unroll
        for (unsigned j = 0; j < 16; ++j) { const unsigned c = xb_ld(&bar[XB_XCNT(j)]); sum += c; cnt += (c > 0u) ? 1u : 0u; mine = (j == x) ? c : mine; }
        if (sum == G) break;
        __builtin_amdgcn_s_sleep(1);
        if ((++sp & 255u) == 0u) { if (xb_ld(&bar[XB_TMO])) break; if (sp > XB_SPIN_CAP) { atomicAdd(&bar[XB_TMO], 1u); break; } }
    }
    nloc = mine > 0u ? mine : 1u; nx = cnt > 0u ? cnt : 1u;
}
__device__ __forceinline__ void xcd_barrier(const XcdBarrier& b) {
    asm volatile("s_waitcnt vmcnt(0)" ::: "memory");
    __syncthreads();
    if (threadIdx.x == 0) {
        unsigned* bar = b.bar;
        __builtin_amdgcn_s_waitcnt(0);
        unsigned nloc = b.st[0], nx = b.st[1];
        if (nloc == 0u) { xcd_barrier_complete(bar, b.x, nloc, nx); b.st[0] = nloc; b.st[1] = nx; }
        const unsigned old = xb_add(&bar[XB_XSUB(b.x)], 1u);
        const unsigned gen = old / nloc;
        if (old + 1u == (gen + 1u) * nloc) {
            __builtin_amdgcn_fence(__ATOMIC_RELEASE, "agent");
            asm volatile("s_waitcnt vmcnt(0)" ::: "memory");
            const unsigned og = xb_add(&bar[XB_TOP], 1u);
            const unsigned tg = og / nx;
            if (og + 1u == (tg + 1u) * nx) xb_add(&bar[XB_TOPGEN], 1u);
            else XB_SPIN(xb_ld(&bar[XB_TOPGEN]) == tg, bar);
            __builtin_amdgcn_fence(__ATOMIC_ACQUIRE, "agent");
            xb_add(&bar[XB_XGEN(b.x)], 1u);
            asm volatile("s_waitcnt vmcnt(0)" ::: "memory");
        } else {
            XB_SPIN(xb_ld(&bar[XB_XGEN(b.x)]) == gen, bar);
            __builtin_amdgcn_fence(__ATOMIC_ACQUIRE, "agent");
            asm volatile("s_waitcnt vmcnt(0)" ::: "memory");
        }
    }
    __syncthreads();
}

struct Args {
    const float* in[34];
    float* out;
    unsigned char* ws;
    int ph_lo, ph_hi;
};

enum { I_X = 0, I_C, I_RELB, I_EADAW, I_EADAB, I_EN1, I_EINW, I_EQN, I_EKN, I_ESINK, I_EOUTW, I_EN2, I_EF1, I_EF3, I_EF2,
       I_OADAW, I_OADAB, I_ON1, I_OINW, I_OCONVW, I_OCONVB, I_ODTBF, I_ODTBB, I_OALF, I_OALB, I_OD, I_OGN, I_OOUTW, I_ON2, I_ORW, I_ORB, I_OM1, I_OM3, I_OM2 };

struct Frame {
    LAS unsigned char* lds;
    unsigned char* ws;
    int tid, lane, wave, G, vcu;
};

__device__ __forceinline__ void tr_item(const float* src  , int srcN, int k0, int n0, bf16* dstrow  , int dstK, LAS float* scr, int lane) {
#pragma unroll 8
    for (int i = 0; i < 32; ++i) { const int kk = 2 * i + (lane >> 5); scr[kk * 33 + (lane & 31)] = src[(size_t)(k0 + kk) * srcN + n0 + (lane & 31)]; }
    LDS_WAIT(); asm volatile("" ::: "memory");
    const int c = lane & 7;
#pragma unroll
    for (int j = 0; j < 4; ++j) { const int n = (lane >> 3) + 8 * j; const LAS float* s = scr + (8 * c) * 33 + n;
        u32x4 o; o.x = pk2(s[0 * 33], s[1 * 33]); o.y = pk2(s[2 * 33], s[3 * 33]); o.z = pk2(s[4 * 33], s[5 * 33]); o.w = pk2(s[6 * 33], s[7 * 33]);
        *(u32x4*)(dstrow + (size_t)n * dstK + k0 + 8 * c) = o; }
    LDS_WAIT(); asm volatile("" ::: "memory");
}

__device__ __forceinline__ void tr_item_fp8(const float* src, int srcN, int k0, int n0, unsigned char* dstrow, int dstK, LAS float* scr, int lane) {
#pragma unroll 8
    for (int i = 0; i < 32; ++i) { const int kk = 2 * i + (lane >> 5); scr[kk * 33 + (lane & 31)] = src[(size_t)(k0 + kk) * srcN + n0 + (lane & 31)]; }
    LDS_WAIT(); asm volatile("" ::: "memory");
    const int c = lane & 3;
#pragma unroll
    for (int j = 0; j < 2; ++j) { const int n = (lane >> 2) + 16 * j; const LAS float* s = scr + (16 * c) * 33 + n;
        u32x4 o;
        o.x = pk4_fp8(64.f * s[0 * 33], 64.f * s[1 * 33], 64.f * s[2 * 33], 64.f * s[3 * 33]); o.y = pk4_fp8(64.f * s[4 * 33], 64.f * s[5 * 33], 64.f * s[6 * 33], 64.f * s[7 * 33]);
        o.z = pk4_fp8(64.f * s[8 * 33], 64.f * s[9 * 33], 64.f * s[10 * 33], 64.f * s[11 * 33]); o.w = pk4_fp8(64.f * s[12 * 33], 64.f * s[13 * 33], 64.f * s[14 * 33], 64.f * s[15 * 33]);
        *(u32x4*)(dstrow + (size_t)n * dstK + k0 + 16 * c) = o; }
    LDS_WAIT(); asm volatile("" ::: "memory");
}

__device__ __forceinline__ void p0_prologue(const Frame& F, const Args& A) {
    const int tid = F.tid, lane = F.lane, wave = F.wave;
    unsigned char* ws = F.ws;
    if (blockIdx.x < 128) {
        const int it = blockIdx.x, kb = it & 15, part = (it >> 4) & 1, g = it >> 5;
        LAS float* tile = (LAS float*)F.lds;
        LAS float* ctab = (LAS float*)(F.lds + 32768);
        const float* Win = A.in[I_EINW];
        for (int i = tid; i < 64 * 128; i += 512) { const int kk = i >> 7, c = i & 127; tile[i] = Win[(size_t)(kb * 64 + kk) * 1280 + g * 128 + c]; }
        if (tid < 128) { const float ang = (float)tid * (6.283185307179586f / 128.0f); ctab[tid] = (part ? sinf(ang) : cosf(ang)) * 0.08838834764831845f; }
        __syncthreads();
        const int m = tid & 127, kq = tid >> 7;
        float accv[16];
#pragma unroll
        for (int j = 0; j < 16; ++j) accv[j] = 0.f;
        for (int c = 0; c < 128; ++c) { const float w = ctab[(m * c) & 127];
#pragma unroll
            for (int j = 0; j < 16; ++j) accv[j] += tile[(kq * 16 + j) * 128 + c] * w; }
        bf16* WU = (bf16*)(ws + WS_WU);
        u32x4 o0, o1;
        o0.x = pk2(accv[0], accv[1]); o0.y = pk2(accv[2], accv[3]); o0.z = pk2(accv[4], accv[5]); o0.w = pk2(accv[6], accv[7]);
        o1.x = pk2(accv[8], accv[9]); o1.y = pk2(accv[10], accv[11]); o1.z = pk2(accv[12], accv[13]); o1.w = pk2(accv[14], accv[15]);
        bf16* dst = WU + (size_t)(part * 512 + g * 128 + m) * 1024 + kb * 64 + kq * 16;
        *(u32x4*)dst = o0; *(u32x4*)(dst + 8) = o1;
        __syncthreads();
    }
    {
        LAS float* ct = (LAS float*)F.lds;
        for (int j = tid; j < 2048; j += 512) ct[j] = cosf((float)j * (6.283185307179586f / 2048.0f)) * 0.022097086912079608f;
        __syncthreads();
        bf16* FD = (bf16*)(ws + WS_FDFT);
        const int nchunk = 2048 * 4096 / 8;
        for (int ch = blockIdx.x * 512 + tid; ch < nchunk; ch += F.G * 512) {
            const int k = ch >> 9, c0 = (ch & 511) * 8;
            float v[8];
#pragma unroll
            for (int e = 0; e < 8; ++e) { const int cc = c0 + e; if (cc < 2048) v[e] = ct[(k * cc) & 2047]; else v[e] = -ct[((k * (cc - 2048)) - 512) & 2047]; }
            u32x4 o; o.x = pk2(v[0], v[1]); o.y = pk2(v[2], v[3]); o.z = pk2(v[4], v[5]); o.w = pk2(v[6], v[7]);
            *(u32x4*)(FD + (size_t)k * 4096 + c0) = o;
        }
        __syncthreads();
    }
    const int gw = F.vcu * 8 + wave, NGW = F.G * 8;
    {
        float* MODP = (float*)(ws + WS_MODP);
        for (int it = gw; it < 192 * 16; it += NGW) {
            const int cg = it % 192, ks = it / 192, l = cg / 96, col = (cg % 96) * 64 + lane;
            const float* W = A.in[l ? I_OADAW : I_EADAW];
            float cs[8], acc8[8];
#pragma unroll
            for (int b = 0; b < 8; ++b) { cs[b] = siluf(A.in[I_C][b * 1024 + ks * 64 + lane]); acc8[b] = 0.f; }
#pragma unroll 8
            for (int kk = 0; kk < 64; ++kk) { const float w = W[(size_t)(ks * 64 + kk) * 6144 + col];
#pragma unroll
                for (int b = 0; b < 8; ++b) acc8[b] += __shfl(cs[b], kk) * w; }
#pragma unroll
            for (int b = 0; b < 8; ++b) MODP[(size_t)ks * 98304 + l * 49152 + b * 6144 + col] = acc8[b];
        }
    }
    {
        LAS float* scr = (LAS float*)(F.lds + wave * 16384);
        constexpr int N1 = 16 * 24, N2 = 16 * 32, N3 = 16 * 88, N5 = 44 * 32, N6 = 16 * 162, N7 = 32 * 32;
        constexpr int NIT = N1 + N2 + 2 * N3 + N5 + N6 + N7;
        for (int it = gw; it < NIT; it += NGW) {
            int r = it;
            if (r < N1) { const int kb = r / 24, nb = r % 24; tr_item(A.in[I_EINW] + 512, 1280, kb * 64, nb * 32, (bf16*)(ws + WS_WQKV) + (size_t)(nb * 32) * 1024, 1024, scr, lane); continue; } r -= N1;
            if (r < N2) { const int kb = r / 32, nb = r % 32; tr_item(A.in[I_EOUTW], 1024, kb * 64, nb * 32, (bf16*)(ws + WS_WO0) + (size_t)(nb * 32) * 1024, 1024, scr, lane); continue; } r -= N2;
            if (r < 2 * N3) { const int w3 = r >= N3; if (w3) r -= N3; const int kb = r / 88, nb = r % 88, n0 = nb * 32, drow = (n0 >> 7) * 256 + (n0 & 127) + (w3 ? 128 : 0);
                tr_item(A.in[w3 ? I_EF3 : I_EF1], DFF, kb * 64, n0, (bf16*)(ws + WS_WF13) + (size_t)drow * 1024, 1024, scr, lane); continue; } r -= 2 * N3;
            if (r < N5) { const int kb = r / 32, nb = r % 32; tr_item(A.in[I_EF2], 1024, kb * 64, nb * 32, (bf16*)(ws + WS_WF2) + (size_t)(nb * 32) * DFF, DFF, scr, lane); continue; } r -= N5;
            if (r < N6) { const int kb = r / 162, nb = r % 162; tr_item(A.in[I_OINW], 5184, kb * 64, nb * 32, (bf16*)(ws + WS_WSIN) + (size_t)(nb * 32) * 1024, 1024, scr, lane); continue; } r -= N6;
            { const int kb = r / 32, nb = r % 32; tr_item(A.in[I_OOUTW], 1024, kb * 64, nb * 32, (bf16*)(ws + WS_WSOUT) + (size_t)(nb * 32) * 2048, 2048, scr, lane); }
        }
    }
}

__device__ __forceinline__ void bg_convert(const Frame& F, const Args& A, int first, int count, int rank, int nranks) {
    constexpr int N8 = 8 * 16 * 112, N10 = 8 * 56 * 32, NMOE = 2 * N8 + N10;
    LAS float* scr = (LAS float*)(F.lds + F.wave * 16384);
    unsigned char* ws = F.ws; const int lane = F.lane;
    const int last = (first + count < NMOE) ? first + count : NMOE;
    for (int it = first + rank; it < last; it += nranks) {
        int r = it;
        if (r < 2 * N8) { const int w3 = r >= N8; if (w3) r -= N8; const int e = r / (16 * 112); r %= 16 * 112; const int kb = r / 112, nb = r % 112, n0 = nb * 32, drow = (n0 >> 7) * 256 + (n0 & 127) + (w3 ? 128 : 0);
            tr_item_fp8(A.in[w3 ? I_OM3 : I_OM1] + (size_t)e * 1024 * DFE, DFE, kb * 64, n0, (unsigned char*)(ws + WS_WM13) + ((size_t)e * 7168 + drow) * 1024, 1024, scr, lane); }
        else { r -= 2 * N8; const int e = r / (56 * 32); r %= 56 * 32; const int kb = r / 32, nb = r % 32;
            tr_item_fp8(A.in[I_OM2] + (size_t)e * DFE * 1024, 1024, kb * 64, nb * 32, (unsigned char*)(ws + WS_WM2) + ((size_t)e * 1024 + nb * 32) * DFE, DFE, scr, lane); }
    }
}
constexpr int NMOE_ITEMS = 2 * 8 * 16 * 112 + 8 * 56 * 32;
constexpr int BGS2 = 512 * BG2, BGS3 = 1024 * BG3, BGS6 = 1024 * BG6;
static_assert(BGS2 + BGS3 + BGS6 <= NMOE_ITEMS, "background budgets");

template <int MODE>
__device__ __forceinline__ void modulate_phase(const Frame& F, const Args& A, const float* xsrc, const float* normw, int layer, int which  ) {
    const int tid = F.tid, lane = F.lane, wave = F.wave;
    unsigned char* ws = F.ws;
    LAS float* sh = (LAS float*)F.lds;
    LAS float* sc = sh + 1024;
    LAS float* nw = sc + 1024;
    LAS float* rw = nw + 1024;
    LAS int* lcnt = (LAS int*)(rw + 8192);
    LAS int* gbase = lcnt + 8;
    LAS int* sel_e = gbase + 8;
    LAS int* sel_p = sel_e + 128;
    LAS float* sel_w = (LAS float*)(sel_p + 128);
    const float* MODP = (const float*)(ws + WS_MODP);
    float* MOD = (float*)(ws + WS_MOD);
    bf16* XN = (bf16*)(ws + WS_XN);
    for (int blk = blockIdx.x; blk < T / 64; blk += F.G) {
        const int row0 = blk * 64, b = row0 / SEQ;
        __syncthreads();
        for (int i = tid; i < 2048; i += 512) {
            const int idx = layer * 49152 + b * 6144 + which * 3072 + i;
            float v;
            if (MODE == 0) { v = A.in[I_EADAB][which * 3072 + i];
#pragma unroll
                for (int ks = 0; ks < 16; ++ks) v += MODP[(size_t)ks * 98304 + idx]; }
            else v = MOD[idx];
            sh[i] = v;
        }
        for (int i = tid; i < 1024; i += 512) nw[i] = normw[i];
        if (MODE == 2) { for (int i = tid; i < 8192; i += 512) { const int e = i >> 10, c = i & 1023; rw[i] = A.in[I_ORW][c * 8 + e]; } if (tid < 8) lcnt[tid] = 0; }
        __syncthreads();
        for (int rr = 0; rr < 8; ++rr) {
            const int lr = wave * 8 + rr, row = row0 + lr;
            const GAS f32x4* xr = (const GAS f32x4*)(xsrc + (size_t)row * D) + lane;
            f32x4 v[4]; float ss = 0.f;
#pragma unroll
            for (int j = 0; j < 4; ++j) { v[j] = xr[64 * j]; ss += (v[j].x * v[j].x + v[j].y * v[j].y) + (v[j].z * v[j].z + v[j].w * v[j].w); }
            const float rstd = 1.0f / sqrtf(wave_sum(ss) * (1.0f / D) + EPS);
            GAS unsigned long long* o8 = (GAS unsigned long long*)(XN + (size_t)row * D) + lane;
            float lg[8];
            if (MODE == 2) {
#pragma unroll
                for (int e = 0; e < 8; ++e) lg[e] = 0.f; }
#pragma unroll
            for (int j = 0; j < 4; ++j) {
                const int c = 4 * lane + 256 * j;
                const f32x4 w4 = *(const LAS f32x4*)(nw + c), s4 = *(const LAS f32x4*)(sc + c), h4 = *(const LAS f32x4*)(sh + c);
                f32x4 y;
                y.x = v[j].x * rstd * w4.x * (1.0f + s4.x) + h4.x; y.y = v[j].y * rstd * w4.y * (1.0f + s4.y) + h4.y;
                y.z = v[j].z * rstd * w4.z * (1.0f + s4.z) + h4.z; y.w = v[j].w * rstd * w4.w * (1.0f + s4.w) + h4.w;
                if (MODE == 2) ((GAS unsigned*)((unsigned char*)XN + (size_t)row * D))[lane + 64 * j] = pk4_fp8(y.x, y.y, y.z, y.w);
                else o8[64 * j] = (unsigned long long)pk2(y.x, y.y) | ((unsigned long long)pk2(y.z, y.w) << 32);
                if (MODE == 2) {
#pragma unroll
                    for (int e = 0; e < 8; ++e) { const f32x4 r4 = *(const LAS f32x4*)(rw + e * 1024 + c); lg[e] += (y.x * r4.x + y.y * r4.y) + (y.z * r4.z + y.w * r4.w); } }
            }
            if (MODE == 2) {
#pragma unroll
                for (int e = 0; e < 8; ++e) lg[e] = wave_sum(lg[e]) + A.in[I_ORB][e];
                int i0 = 0; float v0 = lg[0];
#pragma unroll
                for (int e = 1; e < 8; ++e) if (lg[e] > v0) { v0 = lg[e]; i0 = e; }
                int i1 = -1; float v1 = -3.0e38f;
#pragma unroll
                for (int e = 0; e < 8; ++e) if (e != i0 && lg[e] > v1) { v1 = lg[e]; i1 = e; }
                const float w0 = 1.0f / (1.0f + __expf(v1 - v0)), w1 = 1.0f - w0;
                if (lane == 0) {
                    sel_e[lr * 2] = i0; sel_e[lr * 2 + 1] = i1; sel_w[lr * 2] = w0; sel_w[lr * 2 + 1] = w1;
                    sel_p[lr * 2] = __hip_atomic_fetch_add(lcnt + i0, 1, __ATOMIC_RELAXED, __HIP_MEMORY_SCOPE_WORKGROUP);
                    sel_p[lr * 2 + 1] = __hip_atomic_fetch_add(lcnt + i1, 1, __ATOMIC_RELAXED, __HIP_MEMORY_SCOPE_WORKGROUP);
                }
            }
        }
        if (MODE == 2) {
            __syncthreads();
            unsigned* gcnt = (unsigned*)(ws + WS_CTL) + CW_GCNT;
            if (tid < 8) gbase[tid] = (int)__hip_atomic_fetch_add(gcnt + tid, (unsigned)lcnt[tid], __ATOMIC_RELAXED, __HIP_MEMORY_SCOPE_AGENT);
            __syncthreads();
            if (tid < 128) { const int tok = row0 + (tid >> 1), k = tid & 1, e = sel_e[tid];
                ((int*)(ws + WS_ROUTE + RT_TOKE))[tok * 2 + k] = e;
                ((int*)(ws + WS_ROUTE + RT_TOKP))[tok * 2 + k] = gbase[e] + sel_p[tid];
                ((float*)(ws + WS_ROUTE + RT_TOKW))[tok * 2 + k] = sel_w[tid]; }
        }
    }
    if (MODE == 0) {
        const int idx = blockIdx.x * 384 + tid;
        if (tid < 384 && idx < 98304) { const int l = idx / 49152, col = idx % 6144; float v = A.in[l ? I_OADAB : I_EADAB][col];
#pragma unroll
            for (int ks = 0; ks < 16; ++ks) v += MODP[(size_t)ks * 98304 + idx];
            MOD[idx] = v; }
    }
}

struct SchedPlain {
    const char* A; const char* B; int nM, nN, G, c; size_t tstep;
    __device__ __forceinline__ bool next(int i, Unit& u) const { int pm, pn; if (!pg8::tile_order(i, G, c, nM, nN, pm, pn)) return false; u.pm = pm; u.pn = pn; u.a = A + (size_t)pm * tstep; u.b = B + (size_t)pn * tstep; return true; }
};
struct SchedFourier {
    const char* Fm; const char* UT; int unit;
    __device__ __forceinline__ bool next(int i, Unit& u) const { if (i != 0 || unit < 0) return false; const int b = unit >> 4, idx = unit & 15; u.pm = b * 8 + (idx & 7); u.pn = idx >> 3;
        u.a = Fm + (size_t)(idx & 7) * 256 * 4096 * 2; u.b = UT + ((size_t)b * 512 + (size_t)(idx >> 3) * 256) * 4096 * 2; return true; }
};
struct SchedMoe {
    const char* A; const char* B; const LAS int* pexp; int nM, nN, G, c; size_t tstepA, tstepB; int tiles_per_exp;
    __device__ __forceinline__ bool next(int i, Unit& u) const { int pm, pn; if (!pg8::tile_order(i, G, c, nM, nN, pm, pn)) return false; u.pm = pm; u.pn = pn; const int e = pexp[pm];
        u.a = A + (size_t)pm * tstepA; u.b = B + (size_t)(e * tiles_per_exp + pn) * tstepB; return true; }
};

struct EpiBf16 {
    static constexpr bool PERM = true, FP8 = false;
    bf16* O; int ldc;
    __device__ __forceinline__ void operator()(const f32x4 (&acc)[2][2][4][2], const Unit& u, int wr, int wc, int fr, int fq) const {
        const int row0 = u.pm * 256 + wr * 64 + fr, col0 = u.pn * 256 + wc * 32 + 8 * fq;
#pragma unroll
        for (int ai = 0; ai < 2; ++ai)
#pragma unroll
            for (int m = 0; m < 4; ++m) { bf16* rowp = O + (size_t)(row0 + ai * 128 + m * 16) * ldc + col0;
#pragma unroll
                for (int bj = 0; bj < 2; ++bj) { const f32x4 v0 = acc[ai][bj][m][0], v1 = acc[ai][bj][m][1];
                    u32x4 w; w.x = pk2(v0[0], v0[1]); w.y = pk2(v0[2], v0[3]); w.z = pk2(v1[0], v1[1]); w.w = pk2(v1[2], v1[3]);
                    *(u32x4*)(rowp + bj * 128) = w; } }
    }
};
struct EpiUT {
    static constexpr bool PERM = true, FP8 = false;
    bf16* UT;
    __device__ __forceinline__ void operator()(const f32x4 (&acc)[2][2][4][2], const Unit& u, int wr, int wc, int fr, int fq) const {
        const int part = u.pm >> 1, c0 = (u.pm & 1) * 256 + wr * 64 + fr, b = u.pn >> 3, s0 = (u.pn & 7) * 256 + wc * 32 + 8 * fq;
        bf16* base = UT + ((size_t)b * 512) * 4096 + part * 2048 + s0;
#pragma unroll
        for (int ai = 0; ai < 2; ++ai)
#pragma unroll
            for (int m = 0; m < 4; ++m) { bf16* rowp = base + (size_t)(c0 + ai * 128 + m * 16) * 4096;
#pragma unroll
                for (int bj = 0; bj < 2; ++bj) { const f32x4 v0 = acc[ai][bj][m][0], v1 = acc[ai][bj][m][1];
                    u32x4 w; w.x = pk2(v0[0], v0[1]); w.y = pk2(v0[2], v0[3]); w.z = pk2(v1[0], v1[1]); w.w = pk2(v1[2], v1[3]);
                    *(u32x4*)(rowp + bj * 128) = w; } }
    }
};
struct EpiRes {
    static constexpr bool PERM = false, FP8 = false;
    const float* base; float* out; const float* g;
    __device__ __forceinline__ void operator()(const f32x4 (&acc)[2][2][4][2], const Unit& u, int wr, int wc, int fr, int fq) const {
        const int row0 = u.pm * 256 + wr * 64 + fr, col0 = u.pn * 256 + wc * 32 + 4 * fq, b = (u.pm * 256) / SEQ;
        f32x4 gv[2][2];
#pragma unroll
        for (int bj = 0; bj < 2; ++bj)
#pragma unroll
            for (int n = 0; n < 2; ++n) gv[bj][n] = *(const f32x4*)(g + b * 6144 + col0 + bj * 128 + n * 16);
#pragma unroll
        for (int ai = 0; ai < 2; ++ai)
#pragma unroll
            for (int m = 0; m < 4; ++m) { const size_t off = (size_t)(row0 + ai * 128 + m * 16) * D + col0;
#pragma unroll
                for (int bj = 0; bj < 2; ++bj)
#pragma unroll
                    for (int n = 0; n < 2; ++n) { const f32x4 bs = *(const f32x4*)(base + off + bj * 128 + n * 16);
                        *(f32x4*)(out + off + bj * 128 + n * 16) = bs + gv[bj][n] * acc[ai][bj][m][n]; } }
    }
};
struct EpiSwiglu {
    static constexpr bool PERM = true, FP8 = false;
    bf16* H; int ldc;
    __device__ __forceinline__ void operator()(const f32x4 (&acc)[2][2][4][2], const Unit& u, int wr, int wc, int fr, int fq) const {
        const int row0 = u.pm * 256 + wr * 64 + fr, col0 = u.pn * 128 + wc * 32 + 8 * fq;
#pragma unroll
        for (int ai = 0; ai < 2; ++ai)
#pragma unroll
            for (int m = 0; m < 4; ++m) { bf16* rowp = H + (size_t)(row0 + ai * 128 + m * 16) * ldc + col0;
                float h[8];
#pragma unroll
                for (int n = 0; n < 2; ++n)
#pragma unroll
                    for (int j = 0; j < 4; ++j) { const float a = acc[ai][0][m][n][j], bb = acc[ai][1][m][n][j]; h[n * 4 + j] = a / (1.0f + __expf(-a)) * bb; }
                u32x4 w; w.x = pk2(h[0], h[1]); w.y = pk2(h[2], h[3]); w.z = pk2(h[4], h[5]); w.w = pk2(h[6], h[7]);
                *(u32x4*)rowp = w; }
    }
};
struct EpiSwiglu8 {
    static constexpr bool PERM = true, FP8 = true;
    unsigned char* H; int ldc;
    __device__ __forceinline__ void operator()(const f32x4 (&acc)[2][2][4][2], const Unit& u, int wr, int wc, int fr, int fq) const {
        const int row0 = u.pm * 256 + wr * 64 + fr, col0 = u.pn * 128 + wc * 32 + 8 * fq;
#pragma unroll
        for (int ai = 0; ai < 2; ++ai)
#pragma unroll
            for (int m = 0; m < 4; ++m) { unsigned char* rowp = H + (size_t)(row0 + ai * 128 + m * 16) * ldc + col0;
                float h[8];
#pragma unroll
                for (int n = 0; n < 2; ++n)
#pragma unroll
                    for (int j = 0; j < 4; ++j) { const float a = acc[ai][0][m][n][j] * 0.015625f, bb = acc[ai][1][m][n][j] * 0.015625f; h[n * 4 + j] = a / (1.0f + __expf(-a)) * bb; }
                u32x2 w; w.x = pk4_fp8(h[0], h[1], h[2], h[3]); w.y = pk4_fp8(h[4], h[5], h[6], h[7]);
                *(u32x2*)rowp = w; }
    }
};
struct EpiSsmIn {
    static constexpr bool PERM = true, FP8 = false;
    bf16* Z; bf16* XBC;
    __device__ __forceinline__ void operator()(const f32x4 (&acc)[2][2][4][2], const Unit& u, int wr, int wc, int fr, int fq) const {
        const int row0 = u.pm * 256 + wr * 64 + fr; const bool isz = u.pn < 8;
        bf16* O = isz ? Z : XBC; const int ldc = isz ? 2048 : 3072, col0 = (isz ? u.pn : u.pn - 8) * 256 + wc * 32 + 8 * fq;
#pragma unroll
        for (int ai = 0; ai < 2; ++ai)
#pragma unroll
            for (int m = 0; m < 4; ++m) { bf16* rowp = O + (size_t)(row0 + ai * 128 + m * 16) * ldc + col0;
#pragma unroll
                for (int bj = 0; bj < 2; ++bj) { const f32x4 v0 = acc[ai][bj][m][0], v1 = acc[ai][bj][m][1];
                    u32x4 w; w.x = pk2(v0[0], v0[1]); w.y = pk2(v0[2], v0[3]); w.z = pk2(v1[0], v1[1]); w.w = pk2(v1[2], v1[3]);
                    *(u32x4*)(rowp + bj * 128) = w; } }
    }
};
struct EpiMoeSlot {
    static constexpr bool PERM = true, FP8 = true;
    bf16* YS; const int* rowdst;
    __device__ __forceinline__ void operator()(const f32x4 (&acc)[2][2][4][2], const Unit& u, int wr, int wc, int fr, int fq) const {
        const int row0 = u.pm * 256 + wr * 64 + fr, col0 = u.pn * 256 + wc * 32 + 8 * fq;
#pragma unroll
        for (int ai = 0; ai < 2; ++ai)
#pragma unroll
            for (int m = 0; m < 4; ++m) { const int dst = rowdst[row0 + ai * 128 + m * 16];
                if (dst >= 0) { bf16* rowp = YS + (size_t)dst * D + col0;
#pragma unroll
                    for (int bj = 0; bj < 2; ++bj) { const f32x4 v0 = acc[ai][bj][m][0], v1 = acc[ai][bj][m][1];
                        u32x4 w; w.x = pk2(v0[0] * 0.015625f, v0[1] * 0.015625f); w.y = pk2(v0[2] * 0.015625f, v0[3] * 0.015625f); w.z = pk2(v1[0] * 0.015625f, v1[1] * 0.015625f); w.w = pk2(v1[2] * 0.015625f, v1[3] * 0.015625f);
                        *(u32x4*)(rowp + bj * 128) = w; } } }
    }
};

__device__ __forceinline__ int t5_bucket(int rel) {
    const int n = rel < 0 ? -rel : rel;
    int v = n < 8 ? n : n < 12 ? 8 : n < 16 ? 9 : n < 23 ? 10 : n < 32 ? 11 : n < 46 ? 12 : n < 64 ? 13 : n < 91 ? 14 : 15;
    return (rel > 0 ? 16 : 0) + v;
}
__device__ __forceinline__ void attn_unit(const Frame& F, const Args& A, int b, int nb, int kvh) {
    const int tid = F.tid, lane = F.lane, wave = F.wave, l31 = lane & 31, hh = lane >> 5;
    LAS bf16* Kn = (LAS bf16*)F.lds;
    LAS bf16* VT = (LAS bf16*)(F.lds + 55296);
    LAS float* btab = (LAS float*)(F.lds + 55296 + 50176);
    const bf16* QKV = (const bf16*)(F.ws + WS_QKV);
    bf16* Y = (bf16*)(F.ws + WS_Y0);
    __syncthreads();
    for (int i = 0; i < 6; ++i) {
        const int cid = tid + 512 * i, j = cid >> 3, ch = cid & 7, kpos = nb * 128 - 128 + j;
        const bool ok = kpos >= 0 && kpos < SEQ;
        u32x4 kv = (u32x4){0u, 0u, 0u, 0u}, vv = kv;
        if (ok) { const bf16* rowp = QKV + (size_t)(b * SEQ + kpos) * QKVW; kv = *(const u32x4*)(rowp + 512 + kvh * 64 + ch * 8); vv = *(const u32x4*)(rowp + 640 + kvh * 64 + ch * 8); }
        float kf[8] = {bflo(kv.x), bfhi(kv.x), bflo(kv.y), bfhi(kv.y), bflo(kv.z), bfhi(kv.z), bflo(kv.w), bfhi(kv.w)};
        float ss = 0.f;
#pragma unroll
        for (int e = 0; e < 8; ++e) ss += kf[e] * kf[e];
        ss += __shfl_xor(ss, 1); ss += __shfl_xor(ss, 2); ss += __shfl_xor(ss, 4);
        const float rstd = 1.0f / sqrtf(ss * (1.0f / 64.0f) + EPS);
        const float* kw = A.in[I_EKN] + ch * 8;
        u32x4 o; o.x = pk2(kf[0] * rstd * kw[0], kf[1] * rstd * kw[1]); o.y = pk2(kf[2] * rstd * kw[2], kf[3] * rstd * kw[3]);
        o.z = pk2(kf[4] * rstd * kw[4], kf[5] * rstd * kw[5]); o.w = pk2(kf[6] * rstd * kw[6], kf[7] * rstd * kw[7]);
        *(LAS u32x4*)(Kn + j * 72 + ch * 8) = o;
        const unsigned vw[4] = {vv.x, vv.y, vv.z, vv.w};
#pragma unroll
        for (int e = 0; e < 8; ++e) VT[(ch * 8 + e) * 392 + j] = (bf16)((e & 1) ? (vw[e >> 1] >> 16) : (vw[e >> 1] & 0xffffu));
    }
    for (int i = tid; i < 4 * 257; i += 512) { const int hq = i / 257, ri = i % 257; btab[hq * 260 + ri] = A.in[I_RELB][t5_bucket(ri - 128) * 8 + kvh * 4 + hq]; }
    __syncthreads();
    for (int itn = 0; itn < 2; ++itn) {
        const int it = wave + 8 * itn, hq = it >> 2, rb = it & 3, head = kvh * 4 + hq;
        const int qi = 32 * rb + l31, tok = b * SEQ + nb * 128 + qi;
        bf16x8 Qf[4];
        {
            u32x4 qv[4]; float ss = 0.f;
#pragma unroll
            for (int ks = 0; ks < 4; ++ks) { qv[ks] = *(const u32x4*)(QKV + (size_t)tok * QKVW + head * 64 + 16 * ks + 8 * hh);
                const unsigned w[4] = {qv[ks].x, qv[ks].y, qv[ks].z, qv[ks].w};
#pragma unroll
                for (int e = 0; e < 4; ++e) { const float a = bflo(w[e]), c = bfhi(w[e]); ss += a * a + c * c; } }
            ss += __shfl_xor(ss, 32);
            const float rstd = 0.125f / sqrtf(ss * (1.0f / 64.0f) + EPS);
#pragma unroll
            for (int ks = 0; ks < 4; ++ks) { const float* qw = A.in[I_EQN] + 16 * ks + 8 * hh; const unsigned w[4] = {qv[ks].x, qv[ks].y, qv[ks].z, qv[ks].w};
                u32x4 o; o.x = pk2(bflo(w[0]) * rstd * qw[0], bfhi(w[0]) * rstd * qw[1]); o.y = pk2(bflo(w[1]) * rstd * qw[2], bfhi(w[1]) * rstd * qw[3]);
                o.z = pk2(bflo(w[2]) * rstd * qw[4], bfhi(w[2]) * rstd * qw[5]); o.w = pk2(bflo(w[3]) * rstd * qw[6], bfhi(w[3]) * rstd * qw[7]);
                Qf[ks] = __builtin_bit_cast(bf16x8, o); }
        }
        float mrun = A.in[I_ESINK][head], lsum = hh ? 0.f : 1.0f;
        f32x16 O0, O1;
#pragma unroll
        for (int r = 0; r < 16; ++r) { O0[r] = 0.f; O1[r] = 0.f; }
        for (int tg = 0; tg < 3; ++tg) {
            f32x16 Sa[3];
#pragma unroll
            for (int kt = 0; kt < 3; ++kt) { const int jt = rb + 3 * tg + kt;
#pragma unroll
                for (int r = 0; r < 16; ++r) Sa[kt][r] = 0.f;
#pragma unroll
                for (int ks = 0; ks < 4; ++ks) { const bf16x8 kfr = *(const LAS bf16x8*)(Kn + (32 * jt + l31) * 72 + 16 * ks + 8 * hh);
                    Sa[kt] = __builtin_amdgcn_mfma_f32_32x32x16_bf16(kfr, Qf[ks], Sa[kt], 0, 0, 0); } }
            float gmax = -3.0e38f;
#pragma unroll
            for (int kt = 0; kt < 3; ++kt) { const int jt = rb + 3 * tg + kt;
#pragma unroll
                for (int r = 0; r < 16; ++r) { const int j = 32 * jt + (r & 3) + 8 * (r >> 2) + 4 * hh, rel = j - 128 - qi, kpos = nb * 128 - 128 + j;
                    const bool ok = rel >= -128 && rel <= 128 && kpos >= 0 && kpos < SEQ;
                    const int ridx = ok ? rel + 128 : 0;
                    const float s = ok ? Sa[kt][r] + btab[hq * 260 + ridx] : -INFINITY;
                    Sa[kt][r] = s; gmax = fmaxf(gmax, s); } }
            gmax = fmaxf(gmax, __shfl_xor(gmax, 32));
            const float mnew = fmaxf(mrun, gmax), alpha = __expf(mrun - mnew); mrun = mnew;
            float psum = 0.f;
#pragma unroll
            for (int kt = 0; kt < 3; ++kt)
#pragma unroll
                for (int r = 0; r < 16; ++r) { const float p = __expf(Sa[kt][r] - mnew); Sa[kt][r] = p; psum += p; }
            lsum = lsum * alpha + psum;
#pragma unroll
            for (int r = 0; r < 16; ++r) { O0[r] *= alpha; O1[r] *= alpha; }
#pragma unroll
            for (int kt = 0; kt < 3; ++kt) { const int jt = rb + 3 * tg + kt;
#pragma unroll
                for (int s2 = 0; s2 < 2; ++s2) {
                    u32x4 pw; pw.x = pk2(Sa[kt][8 * s2 + 0], Sa[kt][8 * s2 + 1]); pw.y = pk2(Sa[kt][8 * s2 + 2], Sa[kt][8 * s2 + 3]);
                    pw.z = pk2(Sa[kt][8 * s2 + 4], Sa[kt][8 * s2 + 5]); pw.w = pk2(Sa[kt][8 * s2 + 6], Sa[kt][8 * s2 + 7]);
                    const bf16x8 pf = __builtin_bit_cast(bf16x8, pw);
                    const int kb = 32 * jt + 16 * s2 + 4 * hh;
                    { const u32x2 lo = *(const LAS u32x2*)(VT + l31 * 392 + kb), hi = *(const LAS u32x2*)(VT + l31 * 392 + kb + 8);
                      const u32x4 vw = (u32x4){lo.x, lo.y, hi.x, hi.y}; O0 = __builtin_amdgcn_mfma_f32_32x32x16_bf16(__builtin_bit_cast(bf16x8, vw), pf, O0, 0, 0, 0); }
                    { const u32x2 lo = *(const LAS u32x2*)(VT + (32 + l31) * 392 + kb), hi = *(const LAS u32x2*)(VT + (32 + l31) * 392 + kb + 8);
                      const u32x4 vw = (u32x4){lo.x, lo.y, hi.x, hi.y}; O1 = __builtin_amdgcn_mfma_f32_32x32x16_bf16(__builtin_bit_cast(bf16x8, vw), pf, O1, 0, 0, 0); }
                } }
        }
        lsum += __shfl_xor(lsum, 32);
        const float inv = 1.0f / lsum;
        bf16* yrow = Y + (size_t)tok * D + 512 + head * 64;
#pragma unroll
        for (int q4 = 0; q4 < 4; ++q4) {
            u32x2 w0, w1;
            w0.x = pk2(O0[4 * q4] * inv, O0[4 * q4 + 1] * inv); w0.y = pk2(O0[4 * q4 + 2] * inv, O0[4 * q4 + 3] * inv);
            w1.x = pk2(O1[4 * q4] * inv, O1[4 * q4 + 1] * inv); w1.y = pk2(O1[4 * q4 + 2] * inv, O1[4 * q4 + 3] * inv);
            *(u32x2*)(yrow + 8 * q4 + 4 * hh) = w0; *(u32x2*)(yrow + 32 + 8 * q4 + 4 * hh) = w1;
        }
    }
}

__device__ __forceinline__ void dt_phase(const Frame& F, const Args& A) {
    const int lane = F.lane, wave = F.wave, tid = F.tid, fr = lane & 15, fq = lane >> 4;
    const bf16* XN = (const bf16*)(F.ws + WS_XN);
    const bf16* Wdt = (const bf16*)(F.ws + WS_WSIN) + (size_t)5120 * 1024;
    float* DT = (float*)(F.ws + WS_DT);
    LAS float* part = (LAS float*)F.lds;
    for (int blk = blockIdx.x; blk < T / 64; blk += F.G) {
        const int row0 = blk * 64;
        f32x4 acc[4][4];
#pragma unroll
        for (int m = 0; m < 4; ++m)
#pragma unroll
            for (int n = 0; n < 4; ++n) acc[m][n] = (f32x4){0.f, 0.f, 0.f, 0.f};
#pragma unroll
        for (int ks = 0; ks < 4; ++ks) {
            const int k0 = wave * 128 + ks * 32 + fq * 8;
            bf16x8 af[4], bfm[4];
#pragma unroll
            for (int m = 0; m < 4; ++m) af[m] = *(const bf16x8*)(XN + (size_t)(row0 + m * 16 + fr) * D + k0);
#pragma unroll
            for (int n = 0; n < 4; ++n) bfm[n] = *(const bf16x8*)(Wdt + (size_t)(n * 16 + fr) * D + k0);
#pragma unroll
            for (int m = 0; m < 4; ++m)
#pragma unroll
                for (int n = 0; n < 4; ++n) acc[m][n] = __builtin_amdgcn_mfma_f32_16x16x32_bf16(af[m], bfm[n], acc[m][n], 0, 0, 0);
        }
        __syncthreads();
#pragma unroll
        for (int m = 0; m < 4; ++m)
#pragma unroll
            for (int n = 0; n < 4; ++n)
#pragma unroll
                for (int i = 0; i < 4; ++i) part[wave * 4096 + (m * 16 + 4 * fq + i) * 64 + n * 16 + fr] = acc[m][n][i];
        __syncthreads();
        for (int i = tid; i < 4096; i += 512) {
            float v = 0.f;
#pragma unroll
            for (int w = 0; w < 8; ++w) v += part[w * 4096 + i];
            const int col = i & 63;
            v += (col < 32) ? A.in[I_ODTBF][col] : A.in[I_ODTBB][col - 32];
            const float sp = v > 20.f ? v : log1pf(__expf(v));
            DT[(size_t)(row0 + (i >> 6)) * 64 + col] = sp;
        }
    }
}

constexpr int RS = 136;
constexpr int SL_BN = 0, SL_CN = 34816, SL_XT = 69632, SL_SC = 139264;
constexpr int SQ_BT = 0, SQ_XT = 34816, SQ_ST = 52224, SQ_E = 69632, SQ_W = 70144;
constexpr int SC_REC = 1536;

__device__ __forceinline__ bf16x8 pack8(const f32x16& v, int s2) {
    u32x4 w; w.x = pk2v(v[8 * s2 + 0], v[8 * s2 + 1]); w.y = pk2(v[8 * s2 + 2], v[8 * s2 + 3]); w.z = pk2(v[8 * s2 + 4], v[8 * s2 + 5]); w.w = pk2(v[8 * s2 + 6], v[8 * s2 + 7]);
    return __builtin_bit_cast(bf16x8, w);
}

__device__ __forceinline__ void ssd_local_unit(const Frame& F, const Args& A, int b, int c, int g, int hf) {
    const int tid = F.tid, lane = F.lane, wave = F.wave, l31 = lane & 31, hh = lane >> 5;
    LAS bf16* Bn = (LAS bf16*)(F.lds + SL_BN); LAS bf16* Cn = (LAS bf16*)(F.lds + SL_CN); LAS bf16* XTl = (LAS bf16*)(F.lds + SL_XT);
    LAS float* scl = (LAS float*)(F.lds + SL_SC);
    const bf16* XBC = (const bf16*)(F.ws + WS_XBC);
    bf16* XTg = (bf16*)(F.ws + WS_XT); bf16* BTg = (bf16*)(F.ws + WS_BT); bf16* CNg = (bf16*)(F.ws + WS_CN);
    unsigned char* SCg = F.ws + WS_SC;
    const float* DT = (const float*)(F.ws + WS_DT);
    bf16* YM = (bf16*)(F.ws + WS_YM);
    const int recg = (b * 16 + c) * 4 + g;
    __syncthreads();
    for (int it = tid; it < 1024; it += 512) {
        const int ch8 = it & 63, tg = it >> 6, l0 = tg * 8;
        const int kind = ch8 < 16 ? 1 : (ch8 < 32 ? 2 : 0);
        const int xi = ch8 - 32, hl = xi >> 3;
        const int cc = kind == 1 ? ch8 * 8 : (kind == 2 ? (ch8 - 16) * 8 : (xi & 7) * 8);
        const int h = g * 8 + hf * 4 + hl;
        const int col = kind == 0 ? h * 64 + cc : (kind == 1 ? 2048 + g * 128 + cc : 2560 + g * 128 + cc);
        u32x4 inr[12];
#pragma unroll
        for (int r = 0; r < 12; ++r) { const int pos = c * 128 + l0 + r - 2;
            inr[r] = (u32x4){0u, 0u, 0u, 0u};
            if (pos >= 0 && pos < SEQ) inr[r] = *(const u32x4*)(XBC + (size_t)(b * SEQ + pos) * CDIM + col); }
        float o[8][8];
#pragma unroll
        for (int e = 0; e < 8; ++e) {
            float wv[5];
#pragma unroll
            for (int i = 0; i < 5; ++i) wv[i] = A.in[I_OCONVW][i * CDIM + col + e];
            const float bv = A.in[I_OCONVB][col + e];
            float xin[12];
#pragma unroll
            for (int r = 0; r < 12; ++r) { const unsigned w = (e >> 1) == 0 ? inr[r].x : ((e >> 1) == 1 ? inr[r].y : ((e >> 1) == 2 ? inr[r].z : inr[r].w)); xin[r] = (e & 1) ? bfhi(w) : bflo(w); }
#pragma unroll
            for (int t = 0; t < 8; ++t) { float sacc = bv;
#pragma unroll
                for (int i = 0; i < 5; ++i) sacc += xin[t + i] * wv[i];
                o[t][e] = sacc / (1.0f + __expf(-sacc)); }
        }
        if (kind != 0) {
            LAS bf16* Nn = kind == 1 ? Bn : Cn;
#pragma unroll
            for (int t = 0; t < 8; ++t) { u32x4 w; w.x = pk2v(o[t][0], o[t][1]); w.y = pk2v(o[t][2], o[t][3]); w.z = pk2v(o[t][4], o[t][5]); w.w = pk2v(o[t][6], o[t][7]);
                *(LAS u32x4*)(Nn + (l0 + t) * RS + cc) = w;
                if (kind == 2 && hf == 0) *(u32x4*)(CNg + (size_t)recg * 16384 + (l0 + t) * 128 + cc) = w; }
        }
        if (kind != 2) {
#pragma unroll
            for (int e = 0; e < 8; ++e) { u32x4 w; w.x = pk2v(o[0][e], o[1][e]); w.y = pk2v(o[2][e], o[3][e]); w.z = pk2v(o[4][e], o[5][e]); w.w = pk2v(o[6][e], o[7][e]);
                if (kind == 0) { *(LAS u32x4*)(XTl + hl * (64 * RS) + (cc + e) * RS + l0) = w;
                    *(u32x4*)(XTg + ((size_t)((b * 16 + c) * 32 + h)) * 8192 + (cc + e) * 128 + l0) = w; }
                else if (hf == 0) *(u32x4*)(BTg + (size_t)recg * 16384 + (cc + e) * 128 + l0) = w; }
        }
    }
    {
        const int hl = wave >> 1, dir = wave & 1, h = g * 8 + hf * 4 + hl;
        LAS float* dtv = scl + hl * 512 + dir * 128;
        LAS float* cum = scl + hl * 512 + 256 + dir * 128;
        unsigned char* rec = SCg + (size_t)((b * 16 + c) * 32 + h) * SC_REC;
        const float Ah = -__expf(A.in[dir ? I_OALB : I_OALF][h]);
        const float d0 = DT[(size_t)(b * SEQ + c * 128 + 2 * lane) * 64 + dir * 32 + h], d1 = DT[(size_t)(b * SEQ + c * 128 + 2 * lane + 1) * 64 + dir * 32 + h];
        const float a0 = Ah * d0, a1 = Ah * d1; float s = a0 + a1;
#pragma unroll
        for (int o = 1; o < 64; o <<= 1) { const float t = __shfl_up(s, o); if (lane >= o) s += t; }
        const float tot = __shfl(s, 63);
        float c0, c1;
        if (dir == 0) { c1 = s; c0 = s - a1; } else { c0 = tot - s + a0 + a1; c1 = tot - s + a1; }
        dtv[2 * lane] = d0; dtv[2 * lane + 1] = d1; cum[2 * lane] = c0; cum[2 * lane + 1] = c1;
        float* Eg = (float*)(rec + dir * 512); unsigned* Wg = (unsigned*)(rec + 1024 + dir * 256);
        *(float2*)(Eg + 2 * lane) = make_float2(__expf(c0), __expf(c1));
        Wg[lane] = pk2v(__expf(tot - c0) * d0, __expf(tot - c1) * d1);
    }
    __syncthreads();
    {
        const int hl = wave >> 1, h = g * 8 + hf * 4 + hl;
        LAS float* dtf = scl + hl * 512, *dtb = dtf + 128, *af = dtf + 256, *rbv = dtf + 384;
        LAS bf16* XT = XTl + hl * (64 * RS);
        const float Dh = A.in[I_OD][h];
#pragma unroll 1
        for (int li = 0; li < 2; ++li) {
            const int lt = 2 * (wave & 1) + li, l = 32 * lt + l31;
            const float myaf = af[l], myrb = rbv[l];
            f32x16 Y0, Y1;
#pragma unroll
            for (int r = 0; r < 16; ++r) { Y0[r] = 0.f; Y1[r] = 0.f; }
#pragma unroll 1
            for (int st = 0; st < 4; ++st) {
                f32x16 cb;
#pragma unroll
                for (int r = 0; r < 16; ++r) cb[r] = 0.f;
#pragma unroll
                for (int ks = 0; ks < 8; ++ks) { const bf16x8 cf = *(const LAS bf16x8*)(Cn + l * RS + 16 * ks + 8 * hh);
                    const bf16x8 bfr = *(const LAS bf16x8*)(Bn + (32 * st + l31) * RS + 16 * ks + 8 * hh);
                    cb = __builtin_amdgcn_mfma_f32_32x32x16_bf16(bfr, cf, cb, 0, 0, 0); }
#pragma unroll
                for (int r4 = 0; r4 < 4; ++r4) { const int s0 = 32 * st + 8 * r4 + 4 * hh;
                    const f32x4 afs = *(const LAS f32x4*)(af + s0), rbs = *(const LAS f32x4*)(rbv + s0), dfs = *(const LAS f32x4*)(dtf + s0), dbs = *(const LAS f32x4*)(dtb + s0);
#pragma unroll
                    for (int j = 0; j < 4; ++j) { const int s = s0 + j;
                        const float wgt = (s < l) ? __expf(myaf - afs[j]) * dfs[j] : ((s > l) ? __expf(myrb - rbs[j]) * dbs[j] : (dfs[j] + dbs[j]));
                        cb[4 * r4 + j] *= wgt; } }
#pragma unroll
                for (int s2 = 0; s2 < 2; ++s2) { const int kb = 32 * st + 16 * s2 + 4 * hh; const bf16x8 mf = pack8(cb, s2);
                    { const u32x2 lo = *(const LAS u32x2*)(XT + l31 * RS + kb), hi = *(const LAS u32x2*)(XT + l31 * RS + kb + 8); const u32x4 xw = (u32x4){lo.x, lo.y, hi.x, hi.y};
                      Y0 = __builtin_amdgcn_mfma_f32_32x32x16_bf16(__builtin_bit_cast(bf16x8, xw), mf, Y0, 0, 0, 0); }
                    { const u32x2 lo = *(const LAS u32x2*)(XT + (32 + l31) * RS + kb), hi = *(const LAS u32x2*)(XT + (32 + l31) * RS + kb + 8); const u32x4 xw = (u32x4){lo.x, lo.y, hi.x, hi.y};
                      Y1 = __builtin_amdgcn_mfma_f32_32x32x16_bf16(__builtin_bit_cast(bf16x8, xw), mf, Y1, 0, 0, 0); } }
            }
            bf16* yrow = YM + (size_t)(b * SEQ + c * 128 + l) * DI + h * 64;
#pragma unroll
            for (int q4 = 0; q4 < 4; ++q4) { const int p0 = 8 * q4 + 4 * hh;
                float x0[4], x1[4];
#pragma unroll
                for (int j = 0; j < 4; ++j) { x0[j] = bf1(XT[(p0 + j) * RS + l]); x1[j] = bf1(XT[(32 + p0 + j) * RS + l]); }
                u32x2 w0, w1;
                w0.x = pk2v(Y0[4 * q4] + Dh * x0[0], Y0[4 * q4 + 1] + Dh * x0[1]); w0.y = pk2v(Y0[4 * q4 + 2] + Dh * x0[2], Y0[4 * q4 + 3] + Dh * x0[3]);
                w1.x = pk2v(Y1[4 * q4] + Dh * x1[0], Y1[4 * q4 + 1] + Dh * x1[1]); w1.y = pk2v(Y1[4 * q4 + 2] + Dh * x1[2], Y1[4 * q4 + 3] + Dh * x1[3]);
                *(u32x2*)(yrow + p0) = w0; *(u32x2*)(yrow + 32 + p0) = w1; }
        }
    }
}

__device__ __forceinline__ void ssd_seq_unit(const Frame& F, const Args& A, int b, int h) {
    const int tid = F.tid, lane = F.lane, wave = F.wave, l31 = lane & 31, hh = lane >> 5;
    LAS bf16* BT = (LAS bf16*)(F.lds + SQ_BT); LAS bf16* XT = (LAS bf16*)(F.lds + SQ_XT); LAS bf16* St = (LAS bf16*)(F.lds + SQ_ST);
    LAS float* El = (LAS float*)(F.lds + SQ_E); LAS float* Wl = (LAS float*)(F.lds + SQ_W);
    const bf16* XTg = (const bf16*)(F.ws + WS_XT); const bf16* BTg = (const bf16*)(F.ws + WS_BT); const bf16* CNg = (const bf16*)(F.ws + WS_CN);
    const unsigned char* SCg = F.ws + WS_SC;
    bf16* YM = (bf16*)(F.ws + WS_YM);
    const int g = h >> 3;
    const int lt = wave & 3, pt = wave >> 2;
    const int pt2 = wave & 1, nt = wave >> 1;
    for (int dir = 0; dir < 2; ++dir) {
        u32x4 pb[4], px[2], pc[8]; u32x2 ymn[4]; float pe = 0.f; unsigned pw = 0u;
#define SSD_PREFETCH(cc) do { const size_t rg_ = (size_t)((b * 16 + (cc)) * 4 + g), rh_ = (size_t)((b * 16 + (cc)) * 32 + h); \
        _Pragma("unroll") for (int i_ = 0; i_ < 4; ++i_) pb[i_] = *(const u32x4*)(BTg + rg_ * 16384 + (size_t)(tid + 512 * i_) * 8); \
        _Pragma("unroll") for (int i_ = 0; i_ < 2; ++i_) px[i_] = *(const u32x4*)(XTg + rh_ * 8192 + (size_t)(tid + 512 * i_) * 8); \
        _Pragma("unroll") for (int k_ = 0; k_ < 8; ++k_) pc[k_] = *(const u32x4*)(CNg + rg_ * 16384 + (32 * lt + l31) * 128 + 16 * k_ + 8 * hh); \
        if (tid < 128) { const unsigned char* rec_ = SCg + rh_ * SC_REC; pe = *(const float*)(rec_ + dir * 512 + tid * 4); pw = (unsigned)*(const bf16*)(rec_ + 1024 + dir * 256 + tid * 2); } \
        { const bf16* yr_ = YM + (size_t)(b * SEQ + (cc) * 128 + 32 * lt + l31) * DI + h * 64 + 32 * pt; \
        _Pragma("unroll") for (int q_ = 0; q_ < 4; ++q_) ymn[q_] = *(const u32x2*)(yr_ + 8 * q_ + 4 * hh); } } while (0)
#define SSD_COMMIT() do { \
        _Pragma("unroll") for (int i_ = 0; i_ < 4; ++i_) { const int q_ = tid + 512 * i_; *(LAS u32x4*)(BT + (q_ >> 4) * RS + (q_ & 15) * 8) = pb[i_]; } \
        _Pragma("unroll") for (int i_ = 0; i_ < 2; ++i_) { const int q_ = tid + 512 * i_; *(LAS u32x4*)(XT + (q_ >> 4) * RS + (q_ & 15) * 8) = px[i_]; } \
        if (tid < 128) { El[tid] = pe; Wl[tid] = __uint_as_float(pw << 16); } } while (0)
        __syncthreads();
        SSD_PREFETCH(dir ? 15 : 0);
        for (int i = tid; i < 64 * RS / 2; i += 512) ((LAS unsigned*)St)[i] = 0u;
        SSD_COMMIT();
        f32x16 stacc;
#pragma unroll
        for (int r = 0; r < 16; ++r) stacc[r] = 0.f;
        for (int step = 0; step < 16; ++step) {
            const int c = dir ? 15 - step : step;
            u32x4 cc8[8]; u32x2 ym[4];
#pragma unroll
            for (int k = 0; k < 8; ++k) cc8[k] = pc[k];
#pragma unroll
            for (int q4 = 0; q4 < 4; ++q4) ym[q4] = ymn[q4];
            __syncthreads();
            if (step < 15) SSD_PREFETCH(dir ? 14 - step : step + 1);
            bf16* yrow = YM + (size_t)(b * SEQ + c * 128 + 32 * lt + l31) * DI + h * 64 + 32 * pt;
            f32x16 Yo;
#pragma unroll
            for (int r = 0; r < 16; ++r) Yo[r] = 0.f;
#pragma unroll
            for (int ks = 0; ks < 8; ++ks) { const bf16x8 sf = *(const LAS bf16x8*)(St + (32 * pt + l31) * RS + 16 * ks + 8 * hh);
                Yo = __builtin_amdgcn_mfma_f32_32x32x16_bf16(sf, __builtin_bit_cast(bf16x8, cc8[ks]), Yo, 0, 0, 0); }
            const float e_l = El[32 * lt + l31];
#pragma unroll
            for (int q4 = 0; q4 < 4; ++q4) { u32x2 w;
                w.x = pk2(bflo(ym[q4].x) + e_l * Yo[4 * q4], bfhi(ym[q4].x) + e_l * Yo[4 * q4 + 1]); w.y = pk2(bflo(ym[q4].y) + e_l * Yo[4 * q4 + 2], bfhi(ym[q4].y) + e_l * Yo[4 * q4 + 3]);
                *(u32x2*)(yrow + 8 * q4 + 4 * hh) = w; }
            const float decay = dir ? El[0] : El[127];
#pragma unroll
            for (int r = 0; r < 16; ++r) stacc[r] *= decay;
            const int pp = 32 * pt2 + l31, nn = 32 * nt + l31;
#pragma unroll
            for (int ks = 0; ks < 8; ++ks) { const int l0 = 16 * ks + 8 * hh;
                const u32x4 xr = *(const LAS u32x4*)(XT + pp * RS + l0); const f32x4 w0 = *(const LAS f32x4*)(Wl + l0), w1 = *(const LAS f32x4*)(Wl + l0 + 4);
                u32x4 xs; xs.x = pk2(bflo(xr.x) * w0[0], bfhi(xr.x) * w0[1]); xs.y = pk2(bflo(xr.y) * w0[2], bfhi(xr.y) * w0[3]);
                xs.z = pk2(bflo(xr.z) * w1[0], bfhi(xr.z) * w1[1]); xs.w = pk2(bflo(xr.w) * w1[2], bfhi(xr.w) * w1[3]);
                const bf16x8 bt = *(const LAS bf16x8*)(BT + nn * RS + l0);
                stacc = __builtin_amdgcn_mfma_f32_32x32x16_bf16(__builtin_bit_cast(bf16x8, xs), bt, stacc, 0, 0, 0); }
            __syncthreads();
            if (step < 15) {
                SSD_COMMIT();
#pragma unroll
                for (int r = 0; r < 16; ++r) { const int prow = 32 * pt2 + (r & 3) + 8 * (r >> 2) + 4 * hh; St[prow * RS + nn] = (bf16)(pk2(stacc[r], 0.f) & 0xffffu); }
            }
        }
#undef SSD_PREFETCH
#undef SSD_COMMIT
    }
}

constexpr int SQ2_DIR = 70656, SQ2_BT = 0, SQ2_XT = 34816, SQ2_ST = 52224, SQ2_E = 69632, SQ2_W = 70144;
__device__ __forceinline__ void ssd_seq_unit2(const Frame& F, const Args& A, int b, int h) {
    const int tid = F.tid, lane = F.lane, wave = F.wave, l31 = lane & 31, hh = lane >> 5;
    const int dir = wave >> 2, wj = wave & 3, t256 = tid & 255;
    LAS unsigned char* base = F.lds + dir * SQ2_DIR;
    LAS bf16* BT = (LAS bf16*)(base + SQ2_BT); LAS bf16* XT = (LAS bf16*)(base + SQ2_XT); LAS bf16* St = (LAS bf16*)(base + SQ2_ST);
    LAS float* El = (LAS float*)(base + SQ2_E); LAS float* Wl = (LAS float*)(base + SQ2_W);
    const bf16* XTg = (const bf16*)(F.ws + WS_XT); const bf16* BTg = (const bf16*)(F.ws + WS_BT); const bf16* CNg = (const bf16*)(F.ws + WS_CN);
    const unsigned char* SCg = F.ws + WS_SC;
    bf16* YM = (bf16*)(F.ws + WS_YM);
    const int g = h >> 3, lt = wj, nt = wj;
    u32x4 pb[8], px[4], pc[8], pwv, ymn[4]; float pe = 0.f;
#define SQ2_PF_TILES(cc) do { const size_t rg_ = (size_t)((b * 16 + (cc)) * 4 + g), rh_ = (size_t)((b * 16 + (cc)) * 32 + h); \
        _Pragma("unroll") for (int i_ = 0; i_ < 8; ++i_) pb[i_] = *(const u32x4*)(BTg + rg_ * 16384 + (size_t)(tq + 256 * i_) * 8); \
        _Pragma("unroll") for (int i_ = 0; i_ < 4; ++i_) px[i_] = *(const u32x4*)(XTg + rh_ * 8192 + (size_t)(tq + 256 * i_) * 8); \
        { const unsigned char* rec_ = SCg + rh_ * SC_REC; pwv = *(const u32x4*)(rec_ + 1024 + dir * 256 + (tq & 15) * 16); if (tq < 128) pe = *(const float*)(rec_ + dir * 512 + tq * 4); } } while (0)
#define SQ2_PF_C(cc) do { const size_t rg_ = (size_t)((b * 16 + (cc)) * 4 + g); \
        _Pragma("unroll") for (int k_ = 0; k_ < 8; ++k_) pc[k_] = *(const u32x4*)(CNg + rg_ * 16384 + (32 * lt + (lq & 31)) * 128 + 16 * k_ + 8 * (lq >> 5)); } while (0)
#define SQ2_PF_Y(cc) do { const bf16* yr_ = YM + (size_t)(b * SEQ + (cc) * 128 + 32 * lt + (lq >> 3)) * DI + h * 64 + 8 * (lq & 7); \
        _Pragma("unroll") for (int i_ = 0; i_ < 4; ++i_) ymn[i_] = *(const u32x4*)(yr_ + (size_t)(8 * i_) * DI); } while (0)
#define SQ2_COMMIT() do { \
        _Pragma("unroll") for (int i_ = 0; i_ < 8; ++i_) { const int q_ = t256 + 256 * i_; *(LAS u32x4*)(BT + (q_ >> 4) * RS + (q_ & 15) * 8) = pb[i_]; } \
        _Pragma("unroll") for (int i_ = 0; i_ < 4; ++i_) { const int q_ = t256 + 256 * i_; u32x4 xs_; \
            xs_.x = pk2(bflo(px[i_].x) * bflo(pwv.x), bfhi(px[i_].x) * bfhi(pwv.x)); xs_.y = pk2(bflo(px[i_].y) * bflo(pwv.y), bfhi(px[i_].y) * bfhi(pwv.y)); \
            xs_.z = pk2(bflo(px[i_].z) * bflo(pwv.z), bfhi(px[i_].z) * bfhi(pwv.z)); xs_.w = pk2(bflo(px[i_].w) * bflo(pwv.w), bfhi(px[i_].w) * bfhi(pwv.w)); \
            *(LAS u32x4*)(XT + (q_ >> 4) * RS + (q_ & 15) * 8) = xs_; } \
        if (t256 < 128) El[t256] = pe; } while (0)
    int tq = t256, lq = lane;
    __syncthreads();
    { const int c0 = dir ? 15 : 0; SQ2_PF_TILES(c0); SQ2_PF_C(c0); SQ2_PF_Y(c0); }
    for (int i = t256; i < 64 * RS / 2; i += 256) ((LAS unsigned*)St)[i] = 0u;
    SQ2_COMMIT();
    f32x16 st0, st1;
#pragma unroll
    for (int r = 0; r < 16; ++r) { st0[r] = 0.f; st1[r] = 0.f; }
    for (int step = 0; step < 16; ++step) {
        const int c = dir ? 15 - step : step, cn = dir ? 14 - step : step + 1;
        asm volatile("" : "+v"(tq), "+v"(lq));
        __syncthreads();
        if (step < 15) SQ2_PF_TILES(cn);
        __builtin_amdgcn_sched_barrier(0);
        const float decay = dir ? El[0] : El[127];
#pragma unroll
        for (int r = 0; r < 16; ++r) { st0[r] *= decay; st1[r] *= decay; }
#pragma unroll
        for (int ks = 0; ks < 8; ++ks) { const int l0 = 16 * ks + 8 * hh;
            const bf16x8 bt = *(const LAS bf16x8*)(BT + (32 * nt + l31) * RS + l0);
            const bf16x8 x0 = *(const LAS bf16x8*)(XT + l31 * RS + l0), x1 = *(const LAS bf16x8*)(XT + (32 + l31) * RS + l0);
            st0 = __builtin_amdgcn_mfma_f32_32x32x16_bf16(bt, x0, st0, 0, 0, 0);
            st1 = __builtin_amdgcn_mfma_f32_32x32x16_bf16(bt, x1, st1, 0, 0, 0); }
        __builtin_amdgcn_sched_barrier(0);
        {
            LAS float* scr = (LAS float*)(BT + (32 * nt) * RS);
#pragma unroll
            for (int pt = 0; pt < 2; ++pt) {
                f32x16 Yo;
#pragma unroll
                for (int r = 0; r < 16; ++r) Yo[r] = 0.f;
#pragma unroll
                for (int ks = 0; ks < 8; ++ks) { const bf16x8 sf = *(const LAS bf16x8*)(St + (32 * pt + l31) * RS + 16 * ks + 8 * hh);
                    Yo = __builtin_amdgcn_mfma_f32_32x32x16_bf16(sf, __builtin_bit_cast(bf16x8, pc[ks]), Yo, 0, 0, 0); }
#pragma unroll
                for (int q4 = 0; q4 < 4; ++q4) *(LAS f32x4*)(scr + l31 * 68 + 32 * pt + 8 * q4 + 4 * hh) = (f32x4){Yo[4 * q4], Yo[4 * q4 + 1], Yo[4 * q4 + 2], Yo[4 * q4 + 3]};
            }
            __builtin_amdgcn_sched_barrier(0);
            bf16* yr = YM + (size_t)(b * SEQ + c * 128 + 32 * lt + (lane >> 3)) * DI + h * 64 + 8 * (lane & 7);
#pragma unroll
            for (int i = 0; i < 4; ++i) { const int row = (lane >> 3) + 8 * i; const float e_l = El[32 * lt + row];
                const f32x4 y0 = *(const LAS f32x4*)(scr + row * 68 + 8 * (lane & 7)), y1 = *(const LAS f32x4*)(scr + row * 68 + 8 * (lane & 7) + 4); const u32x4 ym = ymn[i];
                u32x4 w; w.x = pk2(bflo(ym.x) + e_l * y0[0], bfhi(ym.x) + e_l * y0[1]); w.y = pk2(bflo(ym.y) + e_l * y0[2], bfhi(ym.y) + e_l * y0[3]);
                w.z = pk2(bflo(ym.z) + e_l * y1[0], bfhi(ym.z) + e_l * y1[1]); w.w = pk2(bflo(ym.w) + e_l * y1[2], bfhi(ym.w) + e_l * y1[3]);
                *(u32x4*)(yr + (size_t)(8 * i) * DI) = w; }
        }
        __builtin_amdgcn_sched_barrier(0);
        if (step < 15) SQ2_PF_C(cn);
        __syncthreads();
        if (step < 15) {
            SQ2_PF_Y(cn);
            SQ2_COMMIT();
#pragma unroll
            for (int q4 = 0; q4 < 4; ++q4) { const int n0 = 32 * nt + 8 * q4 + 4 * hh;
                u32x2 w0, w1; w0.x = pk2(st0[4 * q4], st0[4 * q4 + 1]); w0.y = pk2(st0[4 * q4 + 2], st0[4 * q4 + 3]); w1.x = pk2(st1[4 * q4], st1[4 * q4 + 1]); w1.y = pk2(st1[4 * q4 + 2], st1[4 * q4 + 3]);
                *(LAS u32x2*)(St + l31 * RS + n0) = w0; *(LAS u32x2*)(St + (32 + l31) * RS + n0) = w1; }
        }
    }
#undef SQ2_PF_TILES
#undef SQ2_PF_C
#undef SQ2_PF_Y
#undef SQ2_COMMIT
}

__device__ __forceinline__ void gnorm_phase(const Frame& F, const Args& A) {
    const int lane = F.lane;
    const bf16* YM = (const bf16*)(F.ws + WS_YM); const bf16* Z = (const bf16*)(F.ws + WS_Z); bf16* YN = (bf16*)(F.ws + WS_YN);
    const float* gw = A.in[I_OGN];
    const int gwv = F.vcu * 8 + F.wave, NGW = F.G * 8;
    for (int row = gwv; row < T; row += NGW) {
        float v[32]; float ss = 0.f;
#pragma unroll
        for (int j = 0; j < 4; ++j) { const int c = 8 * lane + 512 * j;
            const u32x4 y4 = *(const u32x4*)(YM + (size_t)row * DI + c), z4 = *(const u32x4*)(Z + (size_t)row * DI + c);
            const unsigned yw[4] = {y4.x, y4.y, y4.z, y4.w}, zw[4] = {z4.x, z4.y, z4.z, z4.w};
#pragma unroll
            for (int e = 0; e < 4; ++e) { const float a = bflo(yw[e]) * siluf(bflo(zw[e])), c2 = bfhi(yw[e]) * siluf(bfhi(zw[e])); v[j * 8 + 2 * e] = a; v[j * 8 + 2 * e + 1] = c2; ss += a * a + c2 * c2; } }
        const float rstd = 1.0f / sqrtf(wave_sum(ss) * (1.0f / DI) + EPS);
#pragma unroll
        for (int j = 0; j < 4; ++j) { const int c = 8 * lane + 512 * j; const f32x4 g0 = *(const f32x4*)(gw + c), g1 = *(const f32x4*)(gw + c + 4);
            u32x4 o; o.x = pk2(v[j * 8] * rstd * g0[0], v[j * 8 + 1] * rstd * g0[1]); o.y = pk2(v[j * 8 + 2] * rstd * g0[2], v[j * 8 + 3] * rstd * g0[3]);
            o.z = pk2(v[j * 8 + 4] * rstd * g1[0], v[j * 8 + 5] * rstd * g1[1]); o.w = pk2(v[j * 8 + 6] * rstd * g1[2], v[j * 8 + 7] * rstd * g1[3]);
            *(u32x4*)(YN + (size_t)row * DI + c) = o; }
    }
}

__device__ __forceinline__ int moe_tables(const Frame& F, LAS int* pexp  , LAS int* eoff  , LAS int* ecnt  ) {
    const unsigned* gcnt = (const unsigned*)(F.ws + WS_CTL) + CW_GCNT;
    __syncthreads();
    if (F.tid == 0) { int off = 0; for (int e = 0; e < 8; ++e) { const int cnt = (int)__hip_atomic_load(gcnt + e, __ATOMIC_RELAXED, __HIP_MEMORY_SCOPE_AGENT); ecnt[e] = cnt; eoff[e] = off; const int np = (cnt + 255) >> 8;
            for (int p = 0; p < np; ++p) pexp[(off >> 8) + p] = e; off += np << 8; } eoff[8] = off; }
    __syncthreads();
    return eoff[8] >> 8;
}
__device__ __forceinline__ void gather_phase(const Frame& F) {
    LAS int* pexp = (LAS int*)F.lds; LAS int* eoff = pexp + MAXPAN; LAS int* ecnt = eoff + 9;
    const int npan = moe_tables(F, pexp, eoff, ecnt);
    const int* toke = (const int*)(F.ws + WS_ROUTE + RT_TOKE); const int* tokp = (const int*)(F.ws + WS_ROUTE + RT_TOKP); int* rowtok = (int*)(F.ws + WS_ROUTE + RT_ROWTOK);
    const bf16* XN = (const bf16*)(F.ws + WS_XN); bf16* AP = (bf16*)(F.ws + WS_AP);
    const int gwv = F.vcu * 8 + F.wave, NGW = F.G * 8, lane = F.lane;
    for (int i = gwv; i < T * 2; i += NGW) {
        const int e = toke[i], row = eoff[e] + tokp[i], tok = i >> 1;
        if (lane == 0) rowtok[row] = i;
        const u32x4* src = (const u32x4*)((const unsigned char*)XN + (size_t)tok * D); u32x4* dst = (u32x4*)((unsigned char*)AP + (size_t)row * D);
        dst[lane] = src[lane];
    }
    const int npad_total = npan * 256;
    for (int row = gwv; row < npad_total; row += NGW) {
        const int e = pexp[row >> 8];
        if (row >= eoff[e] + ecnt[e]) { if (lane == 0) rowtok[row] = -1;
            u32x4* dst = (u32x4*)((unsigned char*)AP + (size_t)row * D); dst[lane] = (u32x4){0u, 0u, 0u, 0u}; }
    }
}

__device__ __forceinline__ void combine_phase(const Frame& F, const Args& A, float* out) {
    const int lane = F.lane;
    const bf16* YS = (const bf16*)(F.ws + WS_YS); const float* tokw = (const float*)(F.ws + WS_ROUTE + RT_TOKW);
    const float* g2 = (const float*)(F.ws + WS_MOD) + 49152 + 5120;
    const int gwv = F.vcu * 8 + F.wave, NGW = F.G * 8;
    for (int tok = gwv; tok < T; tok += NGW) {
        const float w0 = tokw[2 * tok], w1 = tokw[2 * tok + 1]; const int b = tok / SEQ;
        const bf16* y0 = YS + (size_t)(2 * tok) * D, *y1 = y0 + D; float* orow = out + (size_t)tok * D; const float* gr = g2 + b * 6144;
#pragma unroll
        for (int j = 0; j < 2; ++j) { const int c = 8 * lane + 512 * j;
            const u32x4 a4 = *(const u32x4*)(y0 + c), b4 = *(const u32x4*)(y1 + c);
            const f32x4 g0 = *(const f32x4*)(gr + c), g1 = *(const f32x4*)(gr + c + 4); f32x4 o0 = *(const f32x4*)(orow + c), o1 = *(const f32x4*)(orow + c + 4);
            o0[0] += g0[0] * (w0 * bflo(a4.x) + w1 * bflo(b4.x)); o0[1] += g0[1] * (w0 * bfhi(a4.x) + w1 * bfhi(b4.x));
            o0[2] += g0[2] * (w0 * bflo(a4.y) + w1 * bflo(b4.y)); o0[3] += g0[3] * (w0 * bfhi(a4.y) + w1 * bfhi(b4.y));
            o1[0] += g1[0] * (w0 * bflo(a4.z) + w1 * bflo(b4.z)); o1[1] += g1[1] * (w0 * bfhi(a4.z) + w1 * bfhi(b4.z));
            o1[2] += g1[2] * (w0 * bflo(a4.w) + w1 * bflo(b4.w)); o1[3] += g1[3] * (w0 * bfhi(a4.w) + w1 * bfhi(b4.w));
            *(f32x4*)(orow + c) = o0; *(f32x4*)(orow + c + 4) = o1; }
    }
}

constexpr int NPHASE = 19;
__global__ void __launch_bounds__(512, 2) hybrid_fwd(Args args) {
    extern __shared__ __attribute__((aligned(16))) unsigned char lds_raw[];
    Frame F0;
    F0.lds = (LAS unsigned char*)lds_raw; F0.ws = args.ws;
    F0.tid = threadIdx.x; F0.lane = F0.tid & 63; F0.wave = __builtin_amdgcn_readfirstlane(F0.tid >> 6);
    F0.G = gridDim.x; { const int bx = blockIdx.x; F0.vcu = (F0.G % 8 == 0) ? (bx % 8) * (F0.G / 8) + bx / 8 : bx; }
    volatile LAS unsigned* MISC = (volatile LAS unsigned*)(F0.lds + MISC_OFF);
    if (F0.tid < 32) MISC[F0.tid] = 0u;
    __syncthreads();
    unsigned* ctl = (unsigned*)(args.ws + WS_CTL);
    XcdBarrier bar; bar.bar = ctl + CW_BAR; bar.x = 0; bar.st = nullptr;
#if MK_N_LAUNCHES == 1
    bar = xcd_barrier_post(ctl + CW_BAR, MISC + 8);
#define GRID_BAR() xcd_barrier(bar)
#else
#define GRID_BAR() do { } while (0)
#endif
    const int lo = args.ph_lo, hi = args.ph_hi;
#ifndef PHASE_MASK
#define PHASE_MASK 0x7ffff
#endif
#define IN(k) ((((PHASE_MASK) >> (k)) & 1) && lo <= (k) && (k) < hi)
#define SEAM(k) do { if (IN(k) && IN((k) + 1)) GRID_BAR(); } while (0)
#ifndef REP_PHASE
#define REP_PHASE -1
#endif
#define PHASE_BODY(...) { unsigned char* ws = args.ws; asm volatile("" : "+s"(ws)); Frame F = F0; F.ws = ws; const float* MOD = (const float*)(ws + WS_MOD); (void)MOD; __VA_ARGS__ }
#define PHASE(k, ...) do { if (IN(k)) PHASE_BODY(__VA_ARGS__) if ((REP_PHASE) == (k) && IN(k)) { __syncthreads(); PHASE_BODY(__VA_ARGS__) } } while (0)
    const int c = (int)blockIdx.x;

    PHASE(0,  p0_prologue(F, args); ); SEAM(0);
    PHASE(1,  modulate_phase<0>(F, args, args.in[I_X], args.in[I_EN1], 0, 0); ); SEAM(1);
    PHASE(2,
        { SchedPlain S{(const char*)(ws + WS_WU), (const char*)(ws + WS_XN), 4, 64, F.G, c, (size_t)256 * 1024 * 2}; EpiUT E{(bf16*)(ws + WS_UT)};
          pg8::gemm_phase(F.lds, 2048, S, E); }
        { SchedPlain S{(const char*)(ws + WS_XN), (const char*)(ws + WS_WQKV), 64, 3, F.G, c, (size_t)256 * 1024 * 2}; EpiBf16 E{(bf16*)(ws + WS_QKV), QKVW};
          pg8::gemm_phase(F.lds, 2048, S, E); }
        if (c >= 192) bg_convert(F, args, 0, BGS2, (c - 192) * 8 + F.wave, 512);
    ); SEAM(2);
    PHASE(3,
        const int sub = F.vcu & 31, x = F.vcu >> 5;
        if (sub < 16) { SchedFourier S{(const char*)(ws + WS_FDFT), (const char*)(ws + WS_UT), x * 16 + sub}; EpiBf16 E{(bf16*)(ws + WS_Y0), D};
            pg8::gemm_phase(F.lds, 8192, S, E); }
        else { const int a = sub - 16; attn_unit(F, args, x, a, 0); attn_unit(F, args, x, a, 1); __syncthreads(); bg_convert(F, args, BGS2, BGS3, (x * 16 + a) * 8 + F.wave, 1024); }
    ); SEAM(3);
    PHASE(4,  SchedPlain S{(const char*)(ws + WS_Y0), (const char*)(ws + WS_WO0), 64, 4, F.G, c, (size_t)256 * 1024 * 2}; EpiRes E{args.in[I_X], args.out, MOD + 2048};
        pg8::gemm_phase(F.lds, 2048, S, E); ); SEAM(4);
    PHASE(5,  modulate_phase<1>(F, args, args.out, args.in[I_EN2], 0, 1); ); SEAM(5);
    PHASE(6,  SchedPlain S{(const char*)(ws + WS_XN), (const char*)(ws + WS_WF13), 64, 22, F.G, c, (size_t)256 * 1024 * 2}; EpiSwiglu E{(bf16*)(ws + WS_H0), DFF};
        pg8::gemm_phase(F.lds, 2048, S, E); if (c >= 128) bg_convert(F, args, BGS2 + BGS3, BGS6, (c - 128) * 8 + F.wave, 1024); ); SEAM(6);
    PHASE(7,  SchedPlain S{(const char*)(ws + WS_H0), (const char*)(ws + WS_WF2), 64, 4, F.G, c, (size_t)256 * DFF * 2}; EpiRes E{args.out, args.out, MOD + 5120};
        pg8::gemm_phase(F.lds, DFF * 2, S, E); ); SEAM(7);
    PHASE(8,  modulate_phase<1>(F, args, args.out, args.in[I_ON1], 1, 0); ); SEAM(8);
    PHASE(9,  { SchedPlain S{(const char*)(ws + WS_XN), (const char*)(ws + WS_WSIN), 64, 20, F.G, c, (size_t)256 * 1024 * 2}; EpiSsmIn E{(bf16*)(ws + WS_Z), (bf16*)(ws + WS_XBC)};
        pg8::gemm_phase(F.lds, 2048, S, E); } dt_phase(F, args); ); SEAM(9);
    PHASE(10,  for (int u = F.vcu; u < 1024; u += F.G) ssd_local_unit(F, args, u >> 7, (u >> 3) & 15, (u >> 1) & 3, u & 1); ); SEAM(10);
    PHASE(11,  for (int u = F.vcu; u < NBATCH * NHEAD_SSM; u += F.G) ssd_seq_unit2(F, args, u >> 5, u & 31); ); SEAM(11);
    PHASE(12,  gnorm_phase(F, args); ); SEAM(12);
    PHASE(13,  SchedPlain S{(const char*)(ws + WS_YN), (const char*)(ws + WS_WSOUT), 64, 4, F.G, c, (size_t)256 * DI * 2}; EpiRes E{args.out, args.out, MOD + 49152 + 2048};
        pg8::gemm_phase(F.lds, DI * 2, S, E); ); SEAM(13);
    PHASE(14,  modulate_phase<2>(F, args, args.out, args.in[I_ON2], 1, 1); ); SEAM(14);
    PHASE(15,  bg_convert(F, args, BGS2 + BGS3 + BGS6, NMOE_ITEMS, F.vcu * 8 + F.wave, F.G * 8); __syncthreads(); gather_phase(F); ); SEAM(15);
    PHASE(16,  LAS int* pexp = (LAS int*)(F.lds + 131072 + 4096); LAS int* eoff = pexp + MAXPAN; LAS int* ecnt = eoff + 9;
        const int npan = moe_tables(F, pexp, eoff, ecnt);
        SchedMoe S{(const char*)(ws + WS_AP), (const char*)(ws + WS_WM13), pexp, npan, 28, F.G, c, (size_t)256 * 1024, (size_t)256 * 1024, 28}; EpiSwiglu8 E{(unsigned char*)(ws + WS_HP), DFE};
        pg8::gemm_phase(F.lds, 1024, S, E); ); SEAM(16);
    PHASE(17,  LAS int* pexp = (LAS int*)(F.lds + 131072 + 4096); LAS int* eoff = pexp + MAXPAN; LAS int* ecnt = eoff + 9;
        const int npan = moe_tables(F, pexp, eoff, ecnt);
        SchedMoe S{(const char*)(ws + WS_HP), (const char*)(ws + WS_WM2), pexp, npan, 4, F.G, c, (size_t)256 * DFE, (size_t)256 * DFE, 4};
        EpiMoeSlot E{(bf16*)(ws + WS_YS), (const int*)(ws + WS_ROUTE + RT_ROWTOK)};
        pg8::gemm_phase(F.lds, DFE, S, E);     ); SEAM(17);
    PHASE(18,  combine_phase(F, args, args.out); );
#undef IN
#undef SEAM
}

extern "C" void kernel_launch(void* const* d_in, const int* in_sizes, int n_in, void* d_out, int out_size, void* d_ws, size_t ws_size, hipStream_t stream) {
    static int grid = 0;
    if (grid == 0) {
        if (n_in != 34 || ws_size < WS_END) { grid = -1; return; }
        int dev = 0, cus = 0;
        if (hipGetDevice(&dev) != hipSuccess || hipDeviceGetAttribute(&cus, hipDeviceAttributeMultiprocessorCount, dev) != hipSuccess) { grid = -1; return; }
        if (hipFuncSetAttribute((const void*)hybrid_fwd, hipFuncAttributeMaxDynamicSharedMemorySize, LDS_BYTES) != hipSuccess) { grid = -1; return; }
        int per_cu = 0;
        (void)hipOccupancyMaxActiveBlocksPerMultiprocessor(&per_cu, (const void*)hybrid_fwd, 512, LDS_BYTES);
        (void)hipGetLastError();
        grid = cus;
    }
    if (grid < 0) return;
    (void)hipMemsetAsync((char*)d_ws + WS_CTL, 0, CTL_ZERO_BYTES, stream);
    Args a{};
    for (int i = 0; i < 34; ++i) a.in[i] = (const float*)d_in[i];
    a.out = (float*)d_out; a.ws = (unsigned char*)d_ws;
#if MK_N_LAUNCHES == 1
    a.ph_lo = 0; a.ph_hi = NPHASE;
    hipLaunchKernelGGL(hybrid_fwd, dim3(grid), dim3(512), LDS_BYTES, stream, a);
#else
    for (int p = 0; p < NPHASE; ++p) { a.ph_lo = p; a.ph_hi = p + 1; hipLaunchKernelGGL(hybrid_fwd, dim3(grid), dim3(512), LDS_BYTES, stream, a); }
#endif
}
```
